# Optimizing an MI355X kernel written in HIP

```python
import math
import jax
import jax.numpy as jnp
from jax import lax
import numpy as np

D_MODEL = 1024
BATCH = 8
SEQ = 2048
DEPTH = 2

HEAD_DIM = 64
RWKV_HEADS = 4
RWKV_N = 64
RWKV_W = RWKV_HEADS * RWKV_N
RWKV_DECAY_RANK = 64
RWKV_AAA_RANK = 64
RWKV_GATE_RANK = 128
RWKV_LN_EPS = 64e-5
MLSTM_HEADS = 4
MLSTM_DV = 64
MLSTM_DK = 32
MLSTM_W = MLSTM_HEADS * MLSTM_DV
MLSTM_CONV = 4
MLSTM_CHUNK = 64
GATE_SOFTCAP = 15.0
SWA_Q_HEADS = 4
SWA_KV_HEADS = 2
SWA_WINDOW = 128
SWA_W = SWA_Q_HEADS * HEAD_DIM
SWA_KV_W = SWA_KV_HEADS * HEAD_DIM
FOX_HEADS = 4
FOX_W = FOX_HEADS * HEAD_DIM
ATTN_BLOCK = 128
REL_BUCKETS = 32
REL_MAX_DIST = 128
D_FF = 2816
FFN_CONV = 3
NORM_EPS = 1e-6

RWKV_SPLITS = (RWKV_W, RWKV_W, RWKV_W, RWKV_DECAY_RANK, RWKV_AAA_RANK, RWKV_GATE_RANK)
MLSTM_SPLITS = (2 * MLSTM_HEADS * MLSTM_DK, MLSTM_W, MLSTM_W, MLSTM_HEADS, MLSTM_HEADS)
SWA_SPLITS = (SWA_W, SWA_KV_W, SWA_KV_W)
FOX_SPLITS = (FOX_W, FOX_W, FOX_W, FOX_HEADS)
GROUP_SPLITS = (sum(RWKV_SPLITS), sum(MLSTM_SPLITS), sum(SWA_SPLITS), sum(FOX_SPLITS))
N_IN = sum(GROUP_SPLITS)
D_MIX = RWKV_W + MLSTM_W + SWA_W + FOX_W

kernel_name = 'hybrid_parallel_heads_rwkv7_mlstm_swa_fox'


def _split(z, sizes):
    idx = np.cumsum(sizes)[:-1].tolist()
    return jnp.split(z, idx, axis=-1)


def _rmsnorm(x, g):
    xf = x.astype(jnp.float32)
    return xf * lax.rsqrt(jnp.mean(xf * xf, axis=-1, keepdims=True) + NORM_EPS) * g.astype(jnp.float32)


def _token_shift(u):
    return jnp.pad(u, ((0, 0), (1, 0), (0, 0)))[:, :-1]


def _causal_dwconv(u, w, b):
    k = w.shape[0]
    y = lax.conv_general_dilated(u, w[:, None, :].astype(u.dtype), window_strides=(1,),
                                 padding=[(k - 1, 0)], dimension_numbers=('NWC', 'WIO', 'NWC'),
                                 feature_group_count=u.shape[-1])
    return y + b.astype(u.dtype)


def _t5_bucket(dist):
    max_exact = REL_BUCKETS // 2
    d = np.maximum(dist, 1).astype(np.float32)
    large = max_exact + (np.log(d / max_exact) / math.log(REL_MAX_DIST / max_exact)
                         * (REL_BUCKETS - max_exact)).astype(np.int32)
    large = np.minimum(large, REL_BUCKETS - 1)
    return np.where(dist < max_exact, dist, large).astype(np.int32)


def _rwkv7(z, mu, w0, w_up, a0, a_up, g_up, k_k, k_a, r_k, ln_w, ln_b):
    z = z.astype(jnp.float32)
    z = z + mu * (_token_shift(z) - z)
    r, k, v, wd, ad, gd = _split(z, RWKV_SPLITS)
    bsz, t = r.shape[0], r.shape[1]
    log_decay = -jnp.exp(-jax.nn.softplus(-(w0 + jnp.tanh(wd) @ w_up)) - 0.5)
    decay = jnp.exp(log_decay)
    a = jax.nn.sigmoid(a0 + ad @ a_up)
    g = jax.nn.sigmoid(gd) @ g_up
    heads = lambda u: u.reshape(bsz, t, RWKV_HEADS, RWKV_N)
    kk = heads(k * k_k)
    kk = kk / jnp.maximum(jnp.sqrt(jnp.sum(kk * kk, axis=-1, keepdims=True)), 1e-12)
    k = k * (1.0 + (a - 1.0) * k_a)
    r, k, v, decay, a = heads(r), heads(k), heads(v), heads(decay), heads(a)

    def step(s, inp):
        r_t, w_t, k_t, v_t, kk_t, a_t = inp
        sa = jnp.einsum('bhvk,bhk->bhv', s, -kk_t)
        s = (s * w_t[:, :, None, :] + sa[..., None] * (kk_t * a_t)[:, :, None, :]
             + v_t[..., None] * k_t[:, :, None, :])
        return s, jnp.einsum('bhvk,bhk->bhv', s, r_t)

    xs = tuple(jnp.moveaxis(u, 1, 0) for u in (r, decay, k, v, kk, a))
    s0 = jnp.zeros((bsz, RWKV_HEADS, RWKV_N, RWKV_N), jnp.float32)
    _, y = lax.scan(step, s0, xs)
    y = jnp.moveaxis(y, 0, 1)
    mean = jnp.mean(y, axis=-1, keepdims=True)
    var = jnp.mean(jnp.square(y - mean), axis=-1, keepdims=True)
    y = ((y - mean) * lax.rsqrt(var + RWKV_LN_EPS)).reshape(bsz, t, RWKV_W) * ln_w + ln_b
    bonus = jnp.sum(r * k * r_k, axis=-1, keepdims=True) * v
    return (y + bonus.reshape(bsz, t, RWKV_W)) * g


def _mlstm(z, conv_w, conv_b, b_i, b_f, norm_g):
    z = z.astype(jnp.float32)
    qk, v, o, i_pre, f_pre = _split(z, MLSTM_SPLITS)
    qk = jax.nn.silu(_causal_dwconv(qk, conv_w, conv_b))
    q, k = jnp.split(qk, 2, axis=-1)
    cap = lambda u: GATE_SOFTCAP * jnp.tanh(u / GATE_SOFTCAP)
    li = cap(i_pre + b_i)
    lf = jax.nn.log_sigmoid(cap(f_pre + b_f))
    bsz, t = z.shape[0], z.shape[1]
    nc, L = t // MLSTM_CHUNK, MLSTM_CHUNK

    def chunks(u, d):
        return u.reshape(bsz, nc, L, MLSTM_HEADS, d).transpose(1, 0, 3, 2, 4)

    def gchunks(u):
        return u.reshape(bsz, nc, L, MLSTM_HEADS).transpose(1, 0, 3, 2)

    causal = np.tril(np.ones((L, L), dtype=bool))

    def step(carry, inp):
        c_st, n_st, m_st = carry
        qc, kc, vc, lic, lfc = inp
        b = jnp.cumsum(lfc, axis=-1)
        dmat = jnp.where(causal, b[..., :, None] - b[..., None, :] + lic[..., None, :], -jnp.inf)
        m_inter = b + m_st[..., None]
        m_t = jnp.maximum(m_inter, jnp.max(dmat, axis=-1))
        inter = jnp.exp(m_inter - m_t)
        s = jnp.einsum('bhtk,bhsk->bhts', qc, kc) * jnp.exp(dmat - m_t[..., None])
        num = jnp.einsum('bhts,bhsv->bhtv', s, vc) + inter[..., None] * jnp.einsum('bhvk,bhtk->bhtv', c_st, qc)
        den = jnp.sum(s, axis=-1) + inter * jnp.einsum('bhk,bhtk->bht', n_st, qc)
        h = num / jnp.maximum(jnp.abs(den), jnp.exp(-m_t))[..., None]
        b_last = b[..., -1]
        gexp = b_last[..., None] - b + lic
        m_new = jnp.maximum(b_last + m_st, jnp.max(gexp, axis=-1))
        wts = jnp.exp(gexp - m_new[..., None])
        dec = jnp.exp(b_last + m_st - m_new)
        c_new = dec[..., None, None] * c_st + jnp.einsum('bhs,bhsv,bhsk->bhvk', wts, vc, kc)
        n_new = dec[..., None] * n_st + jnp.einsum('bhs,bhsk->bhk', wts, kc)
        return (c_new, n_new, m_new), h

    xs = (chunks(q * MLSTM_DK ** -0.5, MLSTM_DK), chunks(k, MLSTM_DK), chunks(v, MLSTM_DV), gchunks(li), gchunks(lf))
    init = (jnp.zeros((bsz, MLSTM_HEADS, MLSTM_DV, MLSTM_DK), jnp.float32),
            jnp.zeros((bsz, MLSTM_HEADS, MLSTM_DK), jnp.float32),
            jnp.zeros((bsz, MLSTM_HEADS), jnp.float32))
    _, h = lax.scan(step, init, xs)
    h = h.transpose(1, 0, 3, 2, 4).reshape(bsz, t, MLSTM_HEADS, MLSTM_DV)
    h = h * lax.rsqrt(jnp.mean(h * h, axis=-1, keepdims=True) + NORM_EPS)
    return h.reshape(bsz, t, MLSTM_W) * norm_g * jax.nn.sigmoid(o)


def _swa(z, sinks, rel_bias):
    z = z.astype(jnp.float32)
    q, k, v = _split(z, SWA_SPLITS)
    bsz, t = z.shape[0], z.shape[1]
    nb, blk, grp = t // ATTN_BLOCK, ATTN_BLOCK, SWA_Q_HEADS // SWA_KV_HEADS
    qb = q.reshape(bsz, nb, blk, SWA_KV_HEADS, grp, HEAD_DIM)

    def kv_band(u):
        ub = u.reshape(bsz, nb, blk, SWA_KV_HEADS, HEAD_DIM)
        prev = jnp.pad(ub, ((0, 0), (1, 0), (0, 0), (0, 0), (0, 0)))[:, :-1]
        return jnp.concatenate([prev, ub], axis=2)

    kw, vw = kv_band(k), kv_band(v)
    logits = jnp.einsum('bnqhgd,bnkhd->bnhgqk', qb, kw) * HEAD_DIM ** -0.5
    tq = np.arange(blk)[:, None]
    sk = np.arange(2 * blk)[None, :]
    dist = tq + blk - sk
    in_window = (dist >= 0) & (dist < SWA_WINDOW)
    key_pos = np.arange(nb)[:, None, None] * blk - blk + sk[None]
    mask = in_window[None] & (key_pos >= 0)
    bias = rel_bias[_t5_bucket(np.clip(dist, 0, SWA_WINDOW - 1))].astype(jnp.float32)
    bias = jnp.transpose(bias, (2, 0, 1)).reshape(SWA_KV_HEADS, grp, blk, 2 * blk)
    logits = jnp.where(mask[None, :, None, None], logits + bias, -jnp.inf)
    sink = sinks.astype(jnp.float32).reshape(SWA_KV_HEADS, grp)[None, None, :, :, None, None]
    m = jnp.maximum(jnp.max(logits, axis=-1, keepdims=True), sink)
    p = jnp.exp(logits - m)
    denom = jnp.sum(p, axis=-1, keepdims=True) + jnp.exp(sink - m)
    out = jnp.einsum('bnhgqk,bnkhd->bnqhgd', p / denom, vw)
    return out.reshape(bsz, t, SWA_W)


def _fox(z, b_f):
    z = z.astype(jnp.float32)
    q, k, v, f_pre = _split(z, FOX_SPLITS)
    bsz, t = z.shape[0], z.shape[1]
    nb, blk = t // ATTN_BLOCK, ATTN_BLOCK
    k = k.reshape(bsz, t, FOX_HEADS, HEAD_DIM)
    v = v.reshape(bsz, t, FOX_HEADS, HEAD_DIM)
    c = jnp.cumsum(jax.nn.log_sigmoid(f_pre + b_f), axis=1)
    c_keys = c.transpose(0, 2, 1)
    qb = (q * HEAD_DIM ** -0.5).reshape(bsz, nb, blk, FOX_HEADS, HEAD_DIM).transpose(1, 0, 2, 3, 4)
    cqb = c.reshape(bsz, nb, blk, FOX_HEADS).transpose(1, 0, 3, 2)
    qpos = jnp.arange(t).reshape(nb, blk)
    kpos = jnp.arange(t)

    def block(args):
        qi, cqi, pi = args
        s = jnp.einsum('bqhd,bkhd->bhqk', qi, k) + cqi[..., :, None] - c_keys[:, :, None, :]
        s = jnp.where(kpos[None, :] <= pi[:, None], s, -jnp.inf)
        return jnp.einsum('bhqk,bkhd->bqhd', jax.nn.softmax(s, axis=-1), v)

    out = lax.map(block, (qb, cqb, qpos))
    return out.transpose(1, 0, 2, 3, 4).reshape(bsz, t, FOX_W)


def setup_inputs(seed: int = 0) -> dict:
    key = jax.random.key(seed)
    ks = iter(jax.random.split(key, 40))
    L = DEPTH
    nrm = lambda shape, scale: jax.random.normal(next(ks), shape, jnp.float32) * scale
    uni = lambda shape, lo, hi: jax.random.uniform(next(ks), shape, jnp.float32, lo, hi)
    gain = lambda shape: 1.0 + nrm(shape, 0.05)
    return {
        'x': nrm((BATCH, SEQ, D_MODEL), 1.0),
        'w_in': nrm((L, D_MODEL, N_IN), D_MODEL ** -0.5),
        'w_out': nrm((L, D_MIX, D_MODEL), D_MIX ** -0.5),
        'norm_mix_pre': gain((L, D_MODEL)),
        'norm_mix_post': gain((L, D_MODEL)),
        'norm_ffn_pre': gain((L, D_MODEL)),
        'norm_ffn_post': gain((L, D_MODEL)),
        'rwkv_mu': uni((L, GROUP_SPLITS[0]), 0.0, 1.0),
        'rwkv_w0': uni((L, RWKV_W), -6.0, 1.0),
        'rwkv_w_up': nrm((L, RWKV_DECAY_RANK, RWKV_W), 0.5 * RWKV_DECAY_RANK ** -0.5),
        'rwkv_a0': nrm((L, RWKV_W), 0.5),
        'rwkv_a_up': nrm((L, RWKV_AAA_RANK, RWKV_W), 0.5 * RWKV_AAA_RANK ** -0.5),
        'rwkv_g_up': nrm((L, RWKV_GATE_RANK, RWKV_W), RWKV_GATE_RANK ** -0.5),
        'rwkv_k_k': 0.85 + nrm((L, RWKV_W), 0.05),
        'rwkv_k_a': gain((L, RWKV_W)),
        'rwkv_r_k': nrm((L, RWKV_HEADS, RWKV_N), 0.1),
        'rwkv_ln_w': gain((L, RWKV_W)),
        'rwkv_ln_b': nrm((L, RWKV_W), 0.02),
        'mlstm_conv_w': nrm((L, MLSTM_CONV, 2 * MLSTM_HEADS * MLSTM_DK), MLSTM_CONV ** -0.5),
        'mlstm_conv_b': nrm((L, 2 * MLSTM_HEADS * MLSTM_DK), 0.02),
        'mlstm_b_i': nrm((L, MLSTM_HEADS), 0.5),
        'mlstm_b_f': uni((L, MLSTM_HEADS), 3.0, 6.0),
        'mlstm_norm': gain((L, MLSTM_W)),
        'swa_sinks': nrm((L, SWA_Q_HEADS), 0.5),
        'fox_b_f': uni((L, FOX_HEADS), 2.0, 4.0),
        'rel_bias': nrm((REL_BUCKETS, SWA_Q_HEADS), 0.5),
        'ffn_w_up': nrm((L, D_MODEL, 2 * D_FF), D_MODEL ** -0.5),
        'ffn_conv_w': nrm((L, FFN_CONV, D_FF), FFN_CONV ** -0.5),
        'ffn_conv_b': nrm((L, D_FF), 0.02),
        'ffn_w_down': nrm((L, D_FF, D_MODEL), D_FF ** -0.5),
    }


def reference(x, w_in, w_out, norm_mix_pre, norm_mix_post, norm_ffn_pre, norm_ffn_post,
              rwkv_mu, rwkv_w0, rwkv_w_up, rwkv_a0, rwkv_a_up, rwkv_g_up, rwkv_k_k, rwkv_k_a,
              rwkv_r_k, rwkv_ln_w, rwkv_ln_b, mlstm_conv_w, mlstm_conv_b, mlstm_b_i, mlstm_b_f,
              mlstm_norm, swa_sinks, fox_b_f, rel_bias, ffn_w_up, ffn_conv_w, ffn_conv_b, ffn_w_down):
    dt = x.dtype
    for l in range(DEPTH):
        h = _rmsnorm(x, norm_mix_pre[l]).astype(dt)
        z = h @ w_in[l]
        z_a, z_b, z_c, z_d = _split(z, GROUP_SPLITS)
        y_a = _rwkv7(z_a, rwkv_mu[l], rwkv_w0[l], rwkv_w_up[l], rwkv_a0[l], rwkv_a_up[l], rwkv_g_up[l],
                     rwkv_k_k[l], rwkv_k_a[l], rwkv_r_k[l], rwkv_ln_w[l], rwkv_ln_b[l])
        y_b = _mlstm(z_b, mlstm_conv_w[l], mlstm_conv_b[l], mlstm_b_i[l], mlstm_b_f[l], mlstm_norm[l])
        y_c = _swa(z_c, swa_sinks[l], rel_bias)
        y_d = _fox(z_d, fox_b_f[l])
        y = jnp.concatenate([y_a, y_b, y_c, y_d], axis=-1).astype(dt)
        x = x + _rmsnorm(y @ w_out[l], norm_mix_post[l]).astype(dt)
        h = _rmsnorm(x, norm_ffn_pre[l]).astype(dt)
        gate, up = jnp.split(h @ ffn_w_up[l], 2, axis=-1)
        gate = _causal_dwconv(gate, ffn_conv_w[l], ffn_conv_b[l])
        f = jax.nn.gelu(gate, approximate=True) * up
        x = x + _rmsnorm(f @ ffn_w_down[l], norm_ffn_post[l]).astype(dt)
    return x
```

```cpp
#include <hip/hip_runtime.h>
#include <stdint.h>

typedef unsigned short bf16_t;
#define DEV __device__ __forceinline__

constexpr int BATCH = 8, T = 2048, M = BATCH * T, D = 1024, NIN = 3084, DMIX = 1024, DFF = 2816;
constexpr float NORM_EPS = 1e-6f;

DEV float bf2f(bf16_t v) { return __uint_as_float(((unsigned)v) << 16); }
DEV bf16_t f2bf(float f) { unsigned u = __float_as_uint(f); return (bf16_t)((u + 0x7fffu + ((u >> 16) & 1u)) >> 16); }
DEV float wave_sum(float v) {
#pragma unroll
    for (int o = 1; o < 64; o <<= 1) v += __shfl_xor(v, o);
    return v;
}
DEV float sigmoidf_(float x) { return 1.f / (1.f + expf(-x)); }
DEV float softplusf_(float x) { return fmaxf(x, 0.f) + log1pf(expf(-fabsf(x))); }
DEV float logsigmoidf_(float x) { return fminf(x, 0.f) - log1pf(expf(-fabsf(x))); }

constexpr size_t MiB = 1u << 20;
constexpr size_t WS_Z = 0;
constexpr size_t WS_HN = 100 * MiB;
constexpr size_t WS_Y = 132 * MiB;
constexpr size_t WS_P = 164 * MiB;
constexpr size_t WS_PG = 228 * MiB;
constexpr size_t WS_MISC = 244 * MiB;
constexpr size_t WS_HN2 = 176 * MiB;
constexpr size_t WS_O2 = 176 * MiB;

__global__ void __launch_bounds__(256) n_rmsnorm(const float* __restrict__ x, const float* __restrict__ g, bf16_t* __restrict__ hn) {
    const int row = blockIdx.x * 4 + (threadIdx.x >> 6), lane = threadIdx.x & 63;
    const float* xr = x + (size_t)row * D;
    float v[16]; float s = 0.f;
#pragma unroll
    for (int j = 0; j < 16; ++j) { v[j] = xr[lane + 64 * j]; s += v[j] * v[j]; }
    const float rs = rsqrtf(wave_sum(s) * (1.f / D) + NORM_EPS);
#pragma unroll
    for (int j = 0; j < 16; ++j) hn[(size_t)row * D + lane + 64 * j] = f2bf(v[j] * rs * g[lane + 64 * j]);
}
__global__ void __launch_bounds__(256) n_resnorm(float* __restrict__ x, const float* __restrict__ o, const float* __restrict__ gpost, const float* __restrict__ gpre, bf16_t* __restrict__ hn) {
    const int row = blockIdx.x * 4 + (threadIdx.x >> 6), lane = threadIdx.x & 63;
    float v[16]; float s = 0.f;
#pragma unroll
    for (int j = 0; j < 16; ++j) { v[j] = o[(size_t)row * D + lane + 64 * j]; s += v[j] * v[j]; }
    const float rs = rsqrtf(wave_sum(s) * (1.f / D) + NORM_EPS);
    float s2 = 0.f;
#pragma unroll
    for (int j = 0; j < 16; ++j) { const float xv = x[(size_t)row * D + lane + 64 * j] + v[j] * rs * gpost[lane + 64 * j]; v[j] = xv; s2 += xv * xv; x[(size_t)row * D + lane + 64 * j] = xv; }
    if (hn) {
        const float rs2 = rsqrtf(wave_sum(s2) * (1.f / D) + NORM_EPS);
#pragma unroll
        for (int j = 0; j < 16; ++j) hn[(size_t)row * D + lane + 64 * j] = f2bf(v[j] * rs2 * gpre[lane + 64 * j]);
    }
}

template <bool OUT_BF16>
__global__ void __launch_bounds__(256) n_gemm(const bf16_t* __restrict__ A, int lda, const float* __restrict__ W, int ldw, int N, int K, void* __restrict__ Cv, int ldc) {
    __shared__ float As[16][65];
    __shared__ float Bs[16][64];
    const int tx = threadIdx.x & 15, ty = threadIdx.x >> 4;
    const int row0 = blockIdx.y * 64, col0 = blockIdx.x * 64;
    float acc[4][4] = {};
    for (int k0 = 0; k0 < K; k0 += 16) {
        {
#pragma unroll
            for (int i = 0; i < 4; ++i) { const int e = threadIdx.x + 256 * i, r = e >> 4, kk = e & 15; As[kk][r] = bf2f(A[(size_t)(row0 + r) * lda + k0 + kk]); }
#pragma unroll
            for (int i = 0; i < 4; ++i) { const int e = threadIdx.x + 256 * i, kk = e >> 6, c = e & 63; Bs[kk][c] = (col0 + c < N) ? W[(size_t)(k0 + kk) * ldw + col0 + c] : 0.f; }
        }
        __syncthreads();
#pragma unroll
        for (int kk = 0; kk < 16; ++kk) {
            float a[4], b[4];
#pragma unroll
            for (int i = 0; i < 4; ++i) { a[i] = As[kk][ty * 4 + i]; b[i] = Bs[kk][tx * 4 + i]; }
#pragma unroll
            for (int i = 0; i < 4; ++i)
#pragma unroll
                for (int j = 0; j < 4; ++j) acc[i][j] += a[i] * b[j];
        }
        __syncthreads();
    }
#pragma unroll
    for (int i = 0; i < 4; ++i)
#pragma unroll
        for (int j = 0; j < 4; ++j) { const int r = row0 + ty * 4 + i, c = col0 + tx * 4 + j; if (c < N) { if (OUT_BF16) ((bf16_t*)Cv)[(size_t)r * ldc + c] = f2bf(acc[i][j]); else ((float*)Cv)[(size_t)r * ldc + c] = acc[i][j]; } }
}

__global__ void __launch_bounds__(256) n_rwkv_prep(const bf16_t* __restrict__ z, const float* __restrict__ mu, const float* __restrict__ w0, const float* __restrict__ w_up,
                                                   const float* __restrict__ a0, const float* __restrict__ a_up, const float* __restrict__ g_up, const float* __restrict__ k_k, const float* __restrict__ k_a,
                                                   float* __restrict__ prep, float* __restrict__ gout) {
    __shared__ float zs[1024];
    const int tok = blockIdx.x, t = tok % T, c = threadIdx.x;
#pragma unroll
    for (int j = 0; j < 4; ++j) { const int col = c + 256 * j; const float cur = bf2f(z[(size_t)tok * NIN + col]); const float prv = t > 0 ? bf2f(z[(size_t)(tok - 1) * NIN + col]) : 0.f; zs[col] = cur + mu[col] * (prv - cur); }
    __syncthreads();
    float wp = w0[c], ap = a0[c], gp = 0.f;
    for (int j = 0; j < 64; ++j) { wp += tanhf(zs[768 + j]) * w_up[j * 256 + c]; ap += zs[832 + j] * a_up[j * 256 + c]; }
    for (int j = 0; j < 128; ++j) gp += sigmoidf_(zs[896 + j]) * g_up[j * 256 + c];
    const float w = expf(-expf(-softplusf_(-wp) - 0.5f));
    const float a = sigmoidf_(ap);
    const float kraw = zs[256 + c];
    const float kkp = kraw * k_k[c];
    const float nrm = sqrtf(wave_sum(kkp * kkp));
    const float kk = kkp / fmaxf(nrm, 1e-12f);
    const float kmod = kraw * (1.f + (a - 1.f) * k_a[c]);
    float* p = prep + (size_t)tok * 1024;
    p[c] = w; p[256 + c] = kk; p[512 + c] = kk * a; p[768 + c] = kmod;
    gout[(size_t)tok * 256 + c] = gp;
}
__global__ void __launch_bounds__(64) n_rwkv_scan(const bf16_t* __restrict__ z, const float* __restrict__ mu, const float* __restrict__ prep, const float* __restrict__ gin,
                                                  const float* __restrict__ r_k, const float* __restrict__ ln_w, const float* __restrict__ ln_b, bf16_t* __restrict__ y) {
    __shared__ float sw[64], skk[64], sb[64], sk[64], sr[64];
    const int b = blockIdx.x >> 2, h = blockIdx.x & 3, lane = threadIdx.x, c = h * 64 + lane;
    float S[64];
#pragma unroll
    for (int k = 0; k < 64; ++k) S[k] = 0.f;
    const float mur = mu[c], muv = mu[512 + c], rk = r_k[c], lw = ln_w[c], lb = ln_b[c];
    float zr_prev = 0.f, zv_prev = 0.f;
    for (int t = 0; t < T; ++t) {
        const size_t tok = (size_t)b * T + t;
        const float* p = prep + tok * 1024;
        const float zr = bf2f(z[tok * NIN + c]), zv = bf2f(z[tok * NIN + 512 + c]);
        const float r = zr + mur * (zr_prev - zr), v = zv + muv * (zv_prev - zv);
        zr_prev = zr; zv_prev = zv;
        const float kmod_l = p[768 + c];
        __syncthreads();
        sw[lane] = p[c]; skk[lane] = p[256 + c]; sb[lane] = p[512 + c]; sk[lane] = kmod_l; sr[lane] = r;
        __syncthreads();
        float sa = 0.f;
#pragma unroll
        for (int k = 0; k < 64; ++k) sa -= S[k] * skk[k];
        float yv = 0.f;
#pragma unroll
        for (int k = 0; k < 64; ++k) { S[k] = S[k] * sw[k] + sa * sb[k] + v * sk[k]; yv += S[k] * sr[k]; }
        const float mean = wave_sum(yv) * (1.f / 64.f);
        const float dv = yv - mean;
        const float var = wave_sum(dv * dv) * (1.f / 64.f);
        const float yn = dv * rsqrtf(var + 64e-5f) * lw + lb;
        const float bonus = wave_sum(r * kmod_l * rk) * v;
        y[tok * DMIX + c] = f2bf((yn + bonus) * gin[tok * 256 + c]);
    }
}

__global__ void __launch_bounds__(256) n_mlstm_prep(const bf16_t* __restrict__ z, const float* __restrict__ cw, const float* __restrict__ cb, float* __restrict__ qk) {
    const int tok = blockIdx.x, t = tok % T, c = threadIdx.x;
    float s = cb[c];
#pragma unroll
    for (int j = 0; j < 4; ++j) { const int tt = t - 3 + j; if (tt >= 0) s += cw[j * 256 + c] * bf2f(z[(size_t)(tok - 3 + j) * NIN + 1024 + c]); }
    s = s * sigmoidf_(s);
    if (c < 128) s *= 0.17677669529663687f;
    qk[(size_t)tok * 256 + c] = s;
}
__global__ void __launch_bounds__(64) n_gate_scan(const bf16_t* __restrict__ z, const float* __restrict__ b_i, const float* __restrict__ b_f, const float* __restrict__ fox_bf,
                                                  float* __restrict__ ma, float* __restrict__ mMx, float* __restrict__ mm, float* __restrict__ fc) {
    const int id = threadIdx.x;
    if (id < 32) {
        const int b = id >> 2, h = id & 3; float F = 0.f, pm = -INFINITY;
        for (int t = 0; t < T; ++t) {
            const size_t tok = (size_t)b * T + t;
            const float ip = bf2f(z[tok * NIN + 1792 + h]) + b_i[h], fp = bf2f(z[tok * NIN + 1796 + h]) + b_f[h];
            const float li = 15.f * tanhf(ip * (1.f / 15.f)), lf = logsigmoidf_(15.f * tanhf(fp * (1.f / 15.f)));
            F += lf; const float a = li - F; pm = fmaxf(pm, a); const float Mx = fmaxf(pm, 0.f);
            ma[tok * 4 + h] = a; mMx[tok * 4 + h] = Mx; mm[tok * 4 + h] = F + Mx;
        }
    } else {
        const int b = (id - 32) >> 2, h = id & 3; float c = 0.f;
        for (int t = 0; t < T; ++t) { const size_t tok = (size_t)b * T + t; c += logsigmoidf_(bf2f(z[tok * NIN + 3080 + h]) + fox_bf[h]); fc[tok * 4 + h] = c; }
    }
}
__global__ void __launch_bounds__(64) n_mlstm_attn(const bf16_t* __restrict__ z, const float* __restrict__ qk, const float* __restrict__ ma, const float* __restrict__ mMx, const float* __restrict__ mm,
                                                   const float* __restrict__ norm_g, bf16_t* __restrict__ y) {
    const int bh = blockIdx.y, b = bh >> 2, h = bh & 3, t = blockIdx.x * 64 + threadIdx.x;
    const size_t tok = (size_t)b * T + t;
    float q[32], acc[64];
#pragma unroll
    for (int d = 0; d < 32; ++d) q[d] = qk[tok * 256 + h * 32 + d];
#pragma unroll
    for (int d = 0; d < 64; ++d) acc[d] = 0.f;
    float den = 0.f; const float Mx = mMx[tok * 4 + h];
    const int smax = blockIdx.x * 64 + 63;
    for (int s = 0; s <= smax; ++s) {
        const size_t ts = (size_t)b * T + s;
        float dot = 0.f;
#pragma unroll
        for (int d = 0; d < 32; ++d) dot += q[d] * qk[ts * 256 + 128 + h * 32 + d];
        float sc = (s <= t) ? dot * expf(ma[ts * 4 + h] - Mx) : 0.f;
        den += sc;
#pragma unroll
        for (int d = 0; d < 64; ++d) acc[d] += sc * bf2f(z[ts * NIN + 1280 + h * 64 + d]);
    }
    const float dn = 1.f / fmaxf(fabsf(den), expf(-mm[tok * 4 + h]));
    float ss = 0.f;
#pragma unroll
    for (int d = 0; d < 64; ++d) { acc[d] *= dn; ss += acc[d] * acc[d]; }
    const float rs = rsqrtf(ss * (1.f / 64.f) + NORM_EPS);
#pragma unroll
    for (int d = 0; d < 64; ++d) { const int c = h * 64 + d; y[tok * DMIX + 256 + c] = f2bf(acc[d] * rs * norm_g[c] * sigmoidf_(bf2f(z[tok * NIN + 1536 + c]))); }
}

__constant__ int c_bucket[128] = {0, 1, 2, 3, 4, 5, 6, 7, 8, 9, 10, 11, 12, 13, 14, 15, 16, 16, 16, 17, 17, 18, 18, 18, 19, 19, 19, 20, 20, 20, 20, 21, 21, 21, 21, 22, 22, 22, 22, 22, 23, 23, 23, 23, 23, 23, 24, 24, 24, 24, 24, 24, 25, 25, 25, 25, 25, 25, 25, 26, 26, 26, 26, 26, 26, 26, 26, 27, 27, 27, 27, 27, 27, 27, 27, 27, 27, 28, 28, 28, 28, 28, 28, 28, 28, 28, 28, 29, 29, 29, 29, 29, 29, 29, 29, 29, 29, 29, 29, 30, 30, 30, 30, 30, 30, 30, 30, 30, 30, 30, 30, 30, 30, 31, 31, 31, 31, 31, 31, 31, 31, 31, 31, 31, 31, 31, 31, 31};
__global__ void __launch_bounds__(64) n_swa(const bf16_t* __restrict__ z, const float* __restrict__ sinks, const float* __restrict__ rel_bias, bf16_t* __restrict__ y) {
    const int bh = blockIdx.y, b = bh >> 2, hq = bh & 3, kvh = hq >> 1, t = blockIdx.x * 64 + threadIdx.x;
    const size_t tok = (size_t)b * T + t;
    float q[64], acc[64];
#pragma unroll
    for (int d = 0; d < 64; ++d) { q[d] = bf2f(z[tok * NIN + 1800 + hq * 64 + d]) * 0.125f; acc[d] = 0.f; }
    const float sink = sinks[hq];
    float m = sink, l = 1.f;
    for (int dist = 0; dist < 128; ++dist) {
        const int s = t - dist; if (s < 0) break;
        const size_t ts = (size_t)b * T + s;
        float dot = rel_bias[c_bucket[dist] * 4 + hq];
#pragma unroll
        for (int d = 0; d < 64; ++d) dot += q[d] * bf2f(z[ts * NIN + 2056 + kvh * 64 + d]);
        const float mn = fmaxf(m, dot), f = expf(m - mn), p = expf(dot - mn);
        l = l * f + p; m = mn;
#pragma unroll
        for (int d = 0; d < 64; ++d) acc[d] = acc[d] * f + p * bf2f(z[ts * NIN + 2184 + kvh * 64 + d]);
    }
    const float il = 1.f / l;
#pragma unroll
    for (int d = 0; d < 64; ++d) y[tok * DMIX + 512 + hq * 64 + d] = f2bf(acc[d] * il);
}
__global__ void __launch_bounds__(64) n_fox(const bf16_t* __restrict__ z, const float* __restrict__ fc, bf16_t* __restrict__ y) {
    const int bh = blockIdx.y, b = bh >> 2, h = bh & 3, t = blockIdx.x * 64 + threadIdx.x;
    const size_t tok = (size_t)b * T + t;
    float q[64], acc[64];
#pragma unroll
    for (int d = 0; d < 64; ++d) { q[d] = bf2f(z[tok * NIN + 2312 + h * 64 + d]) * 0.125f; acc[d] = 0.f; }
    float m = -INFINITY, l = 0.f; const float ct = fc[tok * 4 + h];
    const int smax = blockIdx.x * 64 + 63;
    for (int s = 0; s <= smax; ++s) {
        const size_t ts = (size_t)b * T + s;
        float dot = ct - fc[ts * 4 + h];
#pragma unroll
        for (int d = 0; d < 64; ++d) dot += q[d] * bf2f(z[ts * NIN + 2568 + h * 64 + d]);
        if (s <= t) {
            const float mn = fmaxf(m, dot), f = expf(m - mn), p = expf(dot - mn);
            l = l * f + p; m = mn;
#pragma unroll
            for (int d = 0; d < 64; ++d) acc[d] = acc[d] * f + p * bf2f(z[ts * NIN + 2824 + h * 64 + d]);
        }
    }
    const float il = 1.f / l;
#pragma unroll
    for (int d = 0; d < 64; ++d) y[tok * DMIX + 768 + h * 64 + d] = f2bf(acc[d] * il);
}

__global__ void __launch_bounds__(256) n_ffn_act(bf16_t* __restrict__ gu, const float* __restrict__ cw, const float* __restrict__ cb) {
    const int tok = blockIdx.x, t = tok % T;
    for (int c = threadIdx.x; c < DFF; c += 256) {
        float g = cb[c] + cw[2 * DFF + c] * bf2f(gu[(size_t)tok * 5632 + c]);
        if (t >= 1) g += cw[1 * DFF + c] * bf2f(gu[(size_t)(tok - 1) * 5632 + c]);
        if (t >= 2) g += cw[0 * DFF + c] * bf2f(gu[(size_t)(tok - 2) * 5632 + c]);
        const float ge = 0.5f * g * (1.f + tanhf(0.7978845608028654f * (g + 0.044715f * g * g * g)));
        gu[(size_t)tok * 5632 + DFF + c] = f2bf(ge * bf2f(gu[(size_t)tok * 5632 + DFF + c]));
    }
}

extern "C" void kernel_launch(void* const* d_in, const int* in_sizes, int n_in, void* d_out, int out_size, void* d_ws, size_t ws_size, hipStream_t stream) {
    const float* x_in = (const float*)d_in[0];
    float* x = (float*)d_out;
    unsigned char* ws = (unsigned char*)d_ws;
    bf16_t* Z = (bf16_t*)(ws + WS_Z); float* O = (float*)(ws + WS_Z); bf16_t* GU = (bf16_t*)(ws + WS_Z);
    bf16_t* HN = (bf16_t*)(ws + WS_HN); bf16_t* Y = (bf16_t*)(ws + WS_Y);
    float* P = (float*)(ws + WS_P); float* PG = (float*)(ws + WS_PG);
    float* fc = (float*)(ws + WS_MISC); float* ma = fc + (size_t)M * 4; float* mMx = ma + (size_t)M * 4; float* mm = mMx + (size_t)M * 4;
    bf16_t* HN2 = (bf16_t*)(ws + WS_HN2); float* O2 = (float*)(ws + WS_O2);
    hipMemcpyAsync(x, x_in, (size_t)M * D * 4, hipMemcpyDeviceToDevice, stream);
#define IN(i, l, n) ((const float*)d_in[i] + (size_t)(l) * (n))
    n_rmsnorm<<<M / 4, 256, 0, stream>>>(x, IN(3, 0, D), HN);
    for (int l = 0; l < 2; ++l) {
        n_gemm<true><<<dim3((NIN + 63) / 64, M / 64), 256, 0, stream>>>(HN, D, IN(1, l, D * NIN), NIN, NIN, D, Z, NIN);
        n_rwkv_prep<<<M, 256, 0, stream>>>(Z, IN(7, l, 1024), IN(8, l, 256), IN(9, l, 64 * 256), IN(10, l, 256), IN(11, l, 64 * 256), IN(12, l, 128 * 256), IN(13, l, 256), IN(14, l, 256), P, PG);
        n_rwkv_scan<<<32, 64, 0, stream>>>(Z, IN(7, l, 1024), P, PG, IN(15, l, 256), IN(16, l, 256), IN(17, l, 256), Y);
        n_mlstm_prep<<<M, 256, 0, stream>>>(Z, IN(18, l, 4 * 256), IN(19, l, 256), P);
        n_gate_scan<<<1, 64, 0, stream>>>(Z, IN(20, l, 4), IN(21, l, 4), IN(24, l, 4), ma, mMx, mm, fc);
        n_mlstm_attn<<<dim3(T / 64, 32), 64, 0, stream>>>(Z, P, ma, mMx, mm, IN(22, l, 256), Y);
        n_swa<<<dim3(T / 64, 32), 64, 0, stream>>>(Z, IN(23, l, 4), (const float*)d_in[25], Y);
        n_fox<<<dim3(T / 64, 32), 64, 0, stream>>>(Z, fc, Y);
        n_gemm<false><<<dim3(D / 64, M / 64), 256, 0, stream>>>(Y, DMIX, IN(2, l, DMIX * D), D, D, DMIX, O, D);
        n_resnorm<<<M / 4, 256, 0, stream>>>(x, O, IN(4, l, D), IN(5, l, D), HN2);
        n_gemm<true><<<dim3(5632 / 64, M / 64), 256, 0, stream>>>(HN2, D, IN(26, l, D * 5632), 5632, 5632, D, GU, 5632);
        n_ffn_act<<<M, 256, 0, stream>>>(GU, IN(27, l, 3 * DFF), IN(28, l, DFF));
        n_gemm<false><<<dim3(D / 64, M / 64), 256, 0, stream>>>(GU + DFF, 5632, IN(29, l, DFF * D), D, D, DFF, O2, D);
        n_resnorm<<<M / 4, 256, 0, stream>>>(x, O2, IN(6, l, D), l == 0 ? IN(3, 1, D) : nullptr, l == 0 ? HN : nullptr);
    }
#undef IN
}
```

```cpp
#include <hip/hip_runtime.h>
#include <cstdio>
#include <cstdint>
#include <cmath>
namespace pg8 {
#define PG8_LAS __attribute__((address_space(3)))
typedef unsigned short bf16_t;
typedef short bf16x8 __attribute__((ext_vector_type(8)));
typedef float f32x4 __attribute__((ext_vector_type(4)));
typedef unsigned u32x4 __attribute__((ext_vector_type(4)));
constexpr int BM = 256, BK = 64, HALF = 128, HTB = HALF * BK * 2  , STAGE_BYTES = 8 * HTB, NXCD = 8, WGM = 8;

__host__ __device__ __forceinline__ int lds_byte(int r, int c) { const int st = (r >> 4) * 2 + (c >> 5), rr = r & 15, cc = c & 31, ob = rr * 64 + cc * 2; return st * 1024 + (ob ^ (((ob >> 9) & 1) << 5)); }
__host__ __device__ __forceinline__ void stage_rc(int b, int& R, int& C) { const int st = b / 1024, sb = b % 1024, swz = sb ^ (((sb >> 9) & 1) << 5); R = (st >> 1) * 16 + swz / 64; C = (st & 1) * 32 + (swz % 64) / 2; }
__host__ __device__ __forceinline__ int perm32(int rho) { const int n = rho >> 4, i = rho & 15; return 8 * (i >> 2) + 4 * n + (i & 3); }

struct Unit { int pm, pn; };
struct Gemm { const bf16_t* A; const bf16_t* Bt; int M, N, K; };

struct StaticOrder {
    int nM, nN, nwg, G, c;
    __host__ __device__ void init(int M, int N, int G_, int c_) { nM = M / BM; nN = N / BM; nwg = nM * nN; G = G_; c = c_; }
    __host__ __device__ bool next(int i, Unit& u) const {
        const long L = (long)i * G + c; if (L >= nwg) return false;
        int wgid = (int)L; { const int q = nwg / NXCD, r = nwg % NXCD, xcd = wgid % NXCD, off = wgid / NXCD; wgid = (xcd < r ? xcd * (q + 1) : r * (q + 1) + (xcd - r) * q) + off; }
        const int nig = WGM * nN, gid = wgid / nig, fm = gid * WGM, gsz = (nM - fm) < WGM ? (nM - fm) : WGM;
        u.pm = fm + ((wgid % nig) % gsz); u.pn = (wgid % nig) / gsz; return true;
    }
    __device__ __forceinline__ void a_ready(const Unit&) const {}
    __device__ __forceinline__ void done(const Unit&) const {}
};

__device__ __forceinline__ unsigned cvt_pk_bf16(float lo, float hi) { unsigned r; asm volatile("v_cvt_pk_bf16_f32 %0, %1, %2" : "=v"(r) : "v"(lo), "v"(hi)); return r; }
typedef float f32x2 __attribute__((ext_vector_type(2)));
__device__ __forceinline__ f32x2 gelu_pk(f32x2 v) {
    const f32x2 av = __builtin_elementwise_abs(v), d = av * 0.2316418882f + 1.0f;
    f32x2 t; t.x = __builtin_amdgcn_rcpf(d.x); t.y = __builtin_amdgcn_rcpf(d.y);
    f32x2 q = t * 0.5307027145f + (-0.7265760135f); q = q * t + 0.7107068705f; q = q * t + (-0.142248368f); q = q * t + 0.127414796f; q = q * t;
    const f32x2 s = (v * v) * (-0.72134752044f);
    f32x2 e; e.x = __builtin_amdgcn_exp2f(s.x); e.y = __builtin_amdgcn_exp2f(s.y);
    const f32x2 m = v * (q * e), r = v - m;
    f32x2 o; o.x = v.x < 0.f ? m.x : r.x; o.y = v.y < 0.f ? m.y : r.y; return o;
}

template <int ACT  > struct EpiBf16 {
    static constexpr bool PERM = true, AFTER_DRAIN = false; static_assert(ACT == 0 || ACT == 1, "EpiBf16: ACT is 0 (none) or 1 (gelu_pk)");
    bf16_t* O; int ldc; const float* bias; int split_cols; size_t split_stride; float scale0;
    __device__ __forceinline__ void operator()(const f32x4 (&acc)[2][2][4][2], const Unit& u, int wr, int wc, int fr, int fq) const {
        const int row0 = u.pm * BM + wr * 64 + fr; int colt = u.pn * BM; bf16_t* base = O;
        float sc = 1.f; if (split_cols) { const int t = colt / split_cols; base += (size_t)t * split_stride; colt -= t * split_cols; if (t == 0) sc = scale0; }
        const int col0 = colt + wc * 32 + 8 * fq, bcol0 = u.pn * BM + wc * 32 + 8 * fq;
        f32x4 bv[2][2];
#pragma unroll
        for (int bj = 0; bj < 2; ++bj)
#pragma unroll
            for (int n = 0; n < 2; ++n) bv[bj][n] = bias ? *(const f32x4*)(bias + bcol0 + bj * HALF + 4 * n) : (f32x4){0.f, 0.f, 0.f, 0.f};
#pragma unroll
        for (int ai = 0; ai < 2; ++ai)
#pragma unroll
            for (int m = 0; m < 4; ++m) { bf16_t* rowp = base + (size_t)(row0 + ai * HALF + m * 16) * ldc + col0;
#pragma unroll
                for (int bj = 0; bj < 2; ++bj) { f32x4 v0 = acc[ai][bj][m][0] + bv[bj][0], v1 = acc[ai][bj][m][1] + bv[bj][1];
                    if (ACT == 1) { f32x2 a = gelu_pk((f32x2){v0[0], v0[1]}), b = gelu_pk((f32x2){v0[2], v0[3]}), c = gelu_pk((f32x2){v1[0], v1[1]}), d = gelu_pk((f32x2){v1[2], v1[3]});
                        v0 = (f32x4){a.x, a.y, b.x, b.y}; v1 = (f32x4){c.x, c.y, d.x, d.y}; }
                    v0 = v0 * sc; v1 = v1 * sc; u32x4 w; w.x = cvt_pk_bf16(v0[0], v0[1]); w.y = cvt_pk_bf16(v0[2], v0[3]); w.z = cvt_pk_bf16(v1[0], v1[1]); w.w = cvt_pk_bf16(v1[2], v1[3]);
                    *(u32x4*)(rowp + bj * HALF) = w; } }
    }
};
struct EpiF32 {
    static constexpr bool PERM = false, AFTER_DRAIN = false;
    float* C; int ldc;
    __device__ __forceinline__ void operator()(const f32x4 (&acc)[2][2][4][2], const Unit& u, int wr, int wc, int fr, int fq) const {
        const int row0 = u.pm * BM + wr * 64 + fr, col0 = u.pn * BM + wc * 32 + 4 * fq;
#pragma unroll
        for (int ai = 0; ai < 2; ++ai)
#pragma unroll
            for (int m = 0; m < 4; ++m) { float* rowp = C + (size_t)(row0 + ai * HALF + m * 16) * ldc + col0;
#pragma unroll
                for (int bj = 0; bj < 2; ++bj)
#pragma unroll
                    for (int n = 0; n < 2; ++n) *(f32x4*)(rowp + bj * HALF + n * 16) = acc[ai][bj][m][n]; }
    }
};
template <class Epi, class Sched, bool ALIGN_EPI = false, bool SP2 = false>
__device__ __forceinline__ void gemm_phase(PG8_LAS unsigned char* lds, const Gemm g, const Sched& S, const Epi& E) {
    const int tid = threadIdx.x, wid = __builtin_amdgcn_readfirstlane(tid >> 6), lane = tid & 63, wr = wid >> 2, wc = wid & 3, fr = lane & 15, fq = lane >> 4;
    const int K = g.K, nt = K / BK;
    unsigned voffA[2], voffB[2];
#pragma unroll
    for (int i = 0; i < 2; ++i) { int R, C; stage_rc(tid * 16 + i * 8192, R, C); const int Rb = Epi::PERM ? ((R & ~31) + perm32(R & 31)) : R;
        voffA[i] = (unsigned)(R * K + C) * 2u; voffB[i] = (unsigned)(Rb * K + C) * 2u; }
    const size_t kstep = (size_t)(BK * 2);
    const size_t hstep = (size_t)HALF * K * 2;
    const size_t tstep = 2 * hstep;
    const unsigned ldsw = (unsigned)wid * 1024u;
    const int aoff = lds_byte(wr * 64 + fr, fq * 8), boff = lds_byte(wc * 32 + fr, fq * 8);
#define PG8_SA(b, h) (((b) * 2 + (h)) * HTB)
#define PG8_SB(b, h) ((4 + (b) * 2 + (h)) * HTB)
#define PG8_STAGE(bufoff, gbase, voff) do { _Pragma("unroll") for (int _i = 0; _i < 2; ++_i) \
        __builtin_amdgcn_global_load_lds((const unsigned*)((const char*)(gbase) + (voff)[_i]), (PG8_LAS unsigned*)(lds + (bufoff) + ldsw + _i * 8192), 16, 0, 0); } while (0)
#define PG8_LDA(dst, b, h) do { _Pragma("unroll") for (int m = 0; m < 4; ++m) _Pragma("unroll") for (int k = 0; k < 2; ++k) dst[m][k] = *(const PG8_LAS bf16x8*)(lds + PG8_SA(b, h) + aoff + m * 2048 + k * 1024); } while (0)
#define PG8_LDB(dst, b, h) do { _Pragma("unroll") for (int n = 0; n < 2; ++n) _Pragma("unroll") for (int k = 0; k < 2; ++k) dst[n][k] = *(const PG8_LAS bf16x8*)(lds + PG8_SB(b, h) + boff + n * 2048 + k * 1024); } while (0)
#define PG8_MMA(ai, bj, At, Bt) do { __builtin_amdgcn_s_setprio(1); _Pragma("unroll") for (int m = 0; m < 4; ++m) _Pragma("unroll") for (int n = 0; n < 2; ++n) _Pragma("unroll") for (int k = 0; k < 2; ++k) \
        acc[ai][bj][m][n] = __builtin_amdgcn_mfma_f32_16x16x32_bf16(Bt[n][k], At[m][k], acc[ai][bj][m][n], 0, 0, 0); __builtin_amdgcn_s_setprio(0); } while (0)
#define PG8_WAIT_V(n) asm volatile("s_waitcnt vmcnt(" #n ")" ::: "memory")
#define PG8_WAIT_L(n) asm volatile("s_waitcnt lgkmcnt(" #n ")" ::: "memory")
#define PG8_BAR __builtin_amdgcn_s_barrier()
#define PG8_SCHED __builtin_amdgcn_sched_barrier(0)
    Unit cur, nxt; int ui = 0;
    if (!S.next(0, cur)) return;
    f32x4 acc[2][2][4][2];
#pragma unroll
    for (int a = 0; a < 2; ++a)
#pragma unroll
        for (int b = 0; b < 2; ++b)
#pragma unroll
            for (int m = 0; m < 4; ++m)
#pragma unroll
                for (int n = 0; n < 2; ++n) acc[a][b][m][n] = (f32x4){0.f, 0.f, 0.f, 0.f};
    bf16x8 At[4][2], B0[2][2], B1[2][2];
    const char* cA = (const char*)g.A + (size_t)cur.pm * tstep; const char* cB = (const char*)g.Bt + (size_t)cur.pn * tstep;
    S.a_ready(cur);
    if constexpr (SP2) {
        PG8_STAGE(PG8_SB(0, 0), cB, voffB); PG8_STAGE(PG8_SB(0, 1), cB + hstep, voffB); PG8_STAGE(PG8_SA(0, 0), cA, voffA); PG8_STAGE(PG8_SA(0, 1), cA + hstep, voffA);
        if (wr == 1) PG8_BAR;
        PG8_WAIT_V(2); PG8_BAR;
        PG8_STAGE(PG8_SB(1, 0), cB + kstep, voffB); PG8_STAGE(PG8_SA(1, 0), cA + kstep, voffA); PG8_STAGE(PG8_SB(1, 1), cB + hstep + kstep, voffB);
        PG8_WAIT_V(6); PG8_BAR;
    } else {
        PG8_STAGE(PG8_SB(0, 0), cB, voffB); PG8_STAGE(PG8_SA(0, 0), cA, voffA); PG8_STAGE(PG8_SB(0, 1), cB + hstep, voffB); PG8_STAGE(PG8_SA(0, 1), cA + hstep, voffA);
        if (wr == 1) PG8_BAR;
        PG8_WAIT_V(4); PG8_BAR;
        PG8_STAGE(PG8_SB(1, 0), cB + kstep, voffB); PG8_STAGE(PG8_SA(1, 0), cA + kstep, voffA); PG8_STAGE(PG8_SB(1, 1), cB + hstep + kstep, voffB);
        PG8_WAIT_V(6); PG8_BAR;
    }
    for (;;) {
        const bool has_next = S.next(ui + 1, nxt);
        const char* nA = has_next ? (const char*)g.A + (size_t)nxt.pm * tstep : cA; const char* nB = has_next ? (const char*)g.Bt + (size_t)nxt.pn * tstep : cB;
        for (int t = 0; t < nt; t += 2) {
            const bool last = (t == nt - 2);
            const char* a1 = cA + (size_t)(t + 1) * kstep;
            const char* a2 = last ? nA : cA + (size_t)(t + 2) * kstep; const char* b2 = last ? nB : cB + (size_t)(t + 2) * kstep;
            const char* a3 = a2 + kstep; const char* b3 = b2 + kstep;
            if (last && has_next) S.a_ready(nxt);
            if constexpr (SP2) {
            PG8_LDB(B0, 0, 0); PG8_LDB(B1, 0, 1); PG8_SCHED; PG8_LDA(At, 0, 0); PG8_STAGE(PG8_SA(1, 1), a1 + hstep, voffA);
            PG8_WAIT_V(8); PG8_WAIT_L(0); PG8_BAR; PG8_MMA(0, 0, At, B0); PG8_MMA(0, 1, At, B1); PG8_BAR; PG8_SCHED;
            PG8_LDA(At, 0, 1); PG8_STAGE(PG8_SB(0, 0), b2, voffB); PG8_STAGE(PG8_SB(0, 1), b2 + hstep, voffB); PG8_STAGE(PG8_SA(0, 0), a2, voffA);
            PG8_WAIT_V(8); PG8_WAIT_L(0); PG8_BAR; PG8_MMA(1, 0, At, B0); PG8_MMA(1, 1, At, B1); PG8_BAR; PG8_SCHED;
            PG8_LDB(B0, 1, 0); PG8_LDB(B1, 1, 1); PG8_SCHED; PG8_LDA(At, 1, 0); PG8_STAGE(PG8_SA(0, 1), a2 + hstep, voffA);
            PG8_WAIT_V(8); PG8_WAIT_L(0); PG8_BAR; PG8_MMA(0, 0, At, B0); PG8_MMA(0, 1, At, B1); PG8_BAR; PG8_SCHED;
            PG8_LDA(At, 1, 1); PG8_STAGE(PG8_SB(1, 0), b3, voffB); PG8_STAGE(PG8_SB(1, 1), b3 + hstep, voffB); PG8_STAGE(PG8_SA(1, 0), a3, voffA);
            PG8_WAIT_V(8); PG8_WAIT_L(0); PG8_BAR; PG8_MMA(1, 0, At, B0); PG8_MMA(1, 1, At, B1); PG8_BAR; PG8_SCHED;
            } else {
            PG8_LDB(B0, 0, 0); PG8_SCHED; PG8_LDA(At, 0, 0); PG8_STAGE(PG8_SA(1, 1), a1 + hstep, voffA);
            PG8_WAIT_L(8); PG8_BAR; PG8_WAIT_L(0); PG8_MMA(0, 0, At, B0); PG8_BAR; PG8_SCHED;
            PG8_LDB(B1, 0, 1); PG8_STAGE(PG8_SB(0, 0), b2, voffB);
            PG8_BAR; PG8_WAIT_L(0); PG8_MMA(0, 1, At, B1); PG8_BAR;
            PG8_LDA(At, 0, 1); PG8_STAGE(PG8_SA(0, 0), a2, voffA);
            PG8_BAR; PG8_WAIT_L(0); PG8_MMA(1, 0, At, B0); PG8_BAR; PG8_SCHED;
            PG8_STAGE(PG8_SB(0, 1), b2 + hstep, voffB);
            PG8_WAIT_V(6); PG8_BAR; PG8_MMA(1, 1, At, B1); PG8_BAR;
            PG8_LDB(B0, 1, 0); PG8_SCHED; PG8_LDA(At, 1, 0); PG8_STAGE(PG8_SA(0, 1), a2 + hstep, voffA);
            PG8_WAIT_L(8); PG8_BAR; PG8_WAIT_L(0); PG8_MMA(0, 0, At, B0); PG8_BAR; PG8_SCHED;
            PG8_LDB(B1, 1, 1); PG8_STAGE(PG8_SB(1, 0), b3, voffB);
            PG8_BAR; PG8_WAIT_L(0); PG8_MMA(0, 1, At, B1); PG8_BAR;
            PG8_LDA(At, 1, 1); PG8_STAGE(PG8_SA(1, 0), a3, voffA);
            PG8_BAR; PG8_WAIT_L(0); PG8_MMA(1, 0, At, B0); PG8_BAR; PG8_SCHED;
            PG8_STAGE(PG8_SB(1, 1), b3 + hstep, voffB);
            PG8_WAIT_V(6); PG8_BAR; PG8_MMA(1, 1, At, B1); PG8_BAR;
            }
        }
        if constexpr (ALIGN_EPI) { if (wr == 0) PG8_BAR; }
        if constexpr (!Epi::AFTER_DRAIN) { E(acc, cur, wr, wc, fr, fq); S.done(cur); }
        if (!has_next) break;
#pragma unroll
        for (int a = 0; a < 2; ++a)
#pragma unroll
            for (int b = 0; b < 2; ++b)
#pragma unroll
                for (int m = 0; m < 4; ++m)
#pragma unroll
                    for (int n = 0; n < 2; ++n) acc[a][b][m][n] = (f32x4){0.f, 0.f, 0.f, 0.f};
        cur = nxt; cA = nA; cB = nB; ++ui;
        if constexpr (ALIGN_EPI) { if (wr == 1) PG8_BAR; }
    }
    PG8_WAIT_V(0);
    if constexpr (!ALIGN_EPI) { if (wr == 0) PG8_BAR; }
    PG8_BAR;
    if constexpr (Epi::AFTER_DRAIN) { E.fused(acc, cur, wr, wc, fr, fq, lds, wid, lane); S.done(cur); }
#undef PG8_SA
#undef PG8_SB
#undef PG8_STAGE
#undef PG8_LDA
#undef PG8_LDB
#undef PG8_MMA
#undef PG8_WAIT_V
#undef PG8_WAIT_L
#undef PG8_BAR
#undef PG8_SCHED
}
}
constexpr int NWAVES = 8;
#ifndef MK_PER_PHASE
#define MK_PER_PHASE 0
#endif
constexpr int BATCH = 8, T = 2048, M = BATCH * T, D = 1024, NIN = 3084, NZ = 3072, DMIX = 1024, DFF = 2816, NUP = 2 * DFF;
constexpr float NORM_EPS = 1e-6f;
constexpr int PH_PER_LAYER = 10, N_PHASES = 2 * PH_PER_LAYER;

constexpr size_t MiB = 1u << 20;
constexpr size_t WS_CTL = 0, CTL_ZERO_BYTES = 1 * MiB;
constexpr size_t WS_WIN = 1 * MiB;
constexpr size_t WS_WOUT = 7 * MiB;
constexpr size_t WS_WUP = 9 * MiB;
constexpr size_t WS_WDN = 20 * MiB;
constexpr size_t WS_WG = 26 * MiB;
constexpr size_t WS_XN = 27 * MiB;
constexpr size_t WS_R = 59 * MiB;
constexpr size_t WS_Z = WS_R;
constexpr size_t WS_Y = WS_R + 96 * MiB;
constexpr size_t WS_PW = WS_R + 128 * MiB;
constexpr size_t WS_PKK = WS_PW + 16 * MiB;
constexpr size_t WS_PB = WS_PKK + 8 * MiB;
constexpr size_t WS_PKM = WS_PB + 8 * MiB;
constexpr size_t WS_PG = WS_PKM + 8 * MiB;
constexpr size_t WS_O = WS_R;
constexpr size_t WS_GATE = WS_R;
constexpr size_t WS_UP = WS_R + 88 * MiB;
constexpr size_t WS_O2 = WS_R;
constexpr size_t WS_MISC = 235 * MiB;
constexpr size_t WS_QK = 240 * MiB;
constexpr size_t WS_END = 256 * MiB;
constexpr int CW_TMO = 0, CW_BAR = 4096;

constexpr int RING_OFF = 0, RING_BYTES = 131072;
constexpr int LDSCTL_OFF = RING_BYTES, MISC_OFF = LDSCTL_OFF + 320;
constexpr int LDS_BYTES = 147456;

#define GAS __attribute__((address_space(1)))
#define LAS __attribute__((address_space(3)))
typedef unsigned short bf16;
typedef unsigned v4u __attribute__((ext_vector_type(4)));
typedef float f32x4 __attribute__((ext_vector_type(4)));
typedef GAS unsigned gu32;
#define RLX_AGENT __ATOMIC_RELAXED, __HIP_MEMORY_SCOPE_AGENT
#define LDS_WAIT() asm volatile("s_waitcnt lgkmcnt(0)" ::: "memory")
#define DEV __device__ __forceinline__
DEV unsigned f2bf(float f) { unsigned u = __builtin_bit_cast(unsigned, f); return (u + 0x7fffu + ((u >> 16) & 1u)) >> 16; }
DEV unsigned pk2(float lo, float hi) { return f2bf(lo) | (f2bf(hi) << 16); }
DEV float bf2f(bf16 v) { return __uint_as_float(((unsigned)v) << 16); }
DEV float wave_sum(float v) {
#pragma unroll
    for (int o = 1; o < 64; o <<= 1) v += __shfl_xor(v, o);
    return v;
}
DEV float sigmoidf_(float x) { return 1.f / (1.f + expf(-x)); }
DEV float softplusf_(float x) { return fmaxf(x, 0.f) + log1pf(expf(-fabsf(x))); }
DEV float logsigmoidf_(float x) { return fminf(x, 0.f) - log1pf(expf(-fabsf(x))); }

#define XB_TMO      128
#define XB_XCNT(j)  (256  + 64 * (j))
#define XB_XSUB(j)  (1280 + 64 * (j))
#define XB_XGEN(j)  (2304 + 64 * (j))
#define XB_TOP      3328
#define XB_TOPGEN   3392
#define XCD_BAR_WORDS 3456
#define XB_SPIN_CAP (1u << 18)

__device__ __forceinline__ unsigned xb_ld(unsigned* p)              { return __hip_atomic_load(p, __ATOMIC_RELAXED, __HIP_MEMORY_SCOPE_AGENT); }
__device__ __forceinline__ unsigned xb_add(unsigned* p, unsigned v) { return __hip_atomic_fetch_add(p, v, __ATOMIC_RELAXED, __HIP_MEMORY_SCOPE_AGENT); }
__device__ __forceinline__ unsigned xb_xcc_id() { return (unsigned)__builtin_amdgcn_s_getreg((3 << 11) | 20) & 0xFu; }
#define XB_SPIN(cond, bar) do { unsigned _sp = 0; while (cond) { __builtin_amdgcn_s_sleep(1); \
    if ((++_sp & 255u) == 0u) { if (xb_ld(&(bar)[XB_TMO])) break; if (_sp > XB_SPIN_CAP) { atomicAdd(&(bar)[XB_TMO], 1u); break; } } } } while (0)

struct XcdBarrier {
    unsigned* bar; unsigned x;
    volatile LAS unsigned* st;
};

__device__ __forceinline__ XcdBarrier xcd_barrier_post(unsigned* bar, volatile LAS unsigned* st) {
    XcdBarrier b; b.bar = bar; b.x = xb_xcc_id(); b.st = st;
    if (threadIdx.x == 0) (void)xb_add(&bar[XB_XCNT(b.x)], 1u);
    return b;
}
__device__ __forceinline__ void xcd_barrier_complete(unsigned* bar, unsigned x, unsigned& nloc, unsigned& nx) {
    const unsigned G = gridDim.x * gridDim.y * gridDim.z;
    unsigned sum, cnt, mine, sp = 0u;
    for (;;) {
        sum = 0u; cnt = 0u; mine = 0u;
#pragma unroll
        for (unsigned j = 0; j < 16; ++j) { const unsigned c = xb_ld(&bar[XB_XCNT(j)]); sum += c; cnt += (c > 0u) ? 1u : 0u; mine = (j == x) ? c : mine; }
        if (sum == G) break;
        __builtin_amdgcn_s_sleep(1);
        if ((++sp & 255u) == 0u) { if (xb_ld(&bar[XB_TMO])) break; if (sp > XB_SPIN_CAP) { atomicAdd(&bar[XB_TMO], 1u); break; } }
    }
    nloc = mine > 0u ? mine : 1u; nx = cnt > 0u ? cnt : 1u;
}

__device__ __forceinline__ void xcd_barrier(const XcdBarrier& b) {
    asm volatile("s_waitcnt vmcnt(0)" ::: "memory");
    __syncthreads();
    if (threadIdx.x == 0) {
        unsigned* bar = b.bar;
        __builtin_amdgcn_s_waitcnt(0);
        unsigned nloc = b.st[0], nx = b.st[1];
        if (nloc == 0u) { xcd_barrier_complete(bar, b.x, nloc, nx); b.st[0] = nloc; b.st[1] = nx; }
        const unsigned old = xb_add(&bar[XB_XSUB(b.x)], 1u);
        const unsigned gen = old / nloc;
        if (old + 1u == (gen + 1u) * nloc) {
            __builtin_amdgcn_fence(__ATOMIC_RELEASE, "agent");
            asm volatile("s_waitcnt vmcnt(0)" ::: "memory");
            const unsigned og = xb_add(&bar[XB_TOP], 1u);
            const unsigned tg = og / nx;
            if (og + 1u == (tg + 1u) * nx) xb_add(&bar[XB_TOPGEN], 1u);
            else XB_SPIN(xb_ld(&bar[XB_TOPGEN]) == tg, bar);
            __builtin_amdgcn_fence(__ATOMIC_ACQUIRE, "agent");
            xb_add(&bar[XB_XGEN(b.x)], 1u);
            asm volatile("s_waitcnt vmcnt(0)" ::: "memory");
        } else {
            XB_SPIN(xb_ld(&bar[XB_XGEN(b.x)]) == gen, bar);
            __builtin_amdgcn_fence(__ATOMIC_ACQUIRE, "agent");
            asm volatile("s_waitcnt vmcnt(0)" ::: "memory");
        }
    }
    __syncthreads();
}
DEV void p0_transpose_item(const float* W, int ldw, int c0, int ncols, bf16* WT, int K, int row_off, LAS float* scr, int item, int lane) {
    const int nblk = ncols / 32, kb = item / nblk, nb = item % nblk, k0 = 64 * kb, n0 = 32 * nb;
#pragma unroll 8
    for (int i = 0; i < 32; ++i) { const int kk = 2 * i + (lane >> 5); scr[kk * 33 + (lane & 31)] = W[(size_t)(k0 + kk) * ldw + c0 + n0 + (lane & 31)]; }
    LDS_WAIT(); asm volatile("" ::: "memory");
    const int c = lane & 7;
#pragma unroll
    for (int j = 0; j < 4; ++j) { const int n = (lane >> 3) + 8 * j; const LAS float* s = scr + (8 * c) * 33 + n;
        v4u o; o.x = pk2(s[0 * 33], s[1 * 33]); o.y = pk2(s[2 * 33], s[3 * 33]); o.z = pk2(s[4 * 33], s[5 * 33]); o.w = pk2(s[6 * 33], s[7 * 33]);
        *(GAS v4u*)(WT + (size_t)(row_off + n0 + n) * K + k0 + 8 * c) = o; }
    LDS_WAIT(); asm volatile("" ::: "memory");
}
DEV void norm_row(const float* base, const float* o, const float* gpost, float* xout, const float* gpre, bf16* xn, const float* Wg, float* Gr, int lane) {
    f32x4 v[4];
#pragma unroll
    for (int j = 0; j < 4; ++j) v[j] = ((const GAS f32x4*)base)[lane + 64 * j];
    if (o) {
        f32x4 ov[4]; float s = 0.f;
#pragma unroll
        for (int j = 0; j < 4; ++j) { ov[j] = ((const GAS f32x4*)o)[lane + 64 * j]; s += (ov[j].x * ov[j].x + ov[j].y * ov[j].y) + (ov[j].z * ov[j].z + ov[j].w * ov[j].w); }
        const float rs = rsqrtf(wave_sum(s) * (1.f / D) + NORM_EPS);
#pragma unroll
        for (int j = 0; j < 4; ++j) { const f32x4 gp = ((const GAS f32x4*)gpost)[lane + 64 * j]; v[j] = v[j] + ov[j] * rs * gp; }
    }
    if (xout) {
#pragma unroll
        for (int j = 0; j < 4; ++j) ((GAS f32x4*)xout)[lane + 64 * j] = v[j];
    }
    if (xn) {
        float s = 0.f;
#pragma unroll
        for (int j = 0; j < 4; ++j) s += (v[j].x * v[j].x + v[j].y * v[j].y) + (v[j].z * v[j].z + v[j].w * v[j].w);
        const float rs = rsqrtf(wave_sum(s) * (1.f / D) + NORM_EPS);
#pragma unroll
        for (int j = 0; j < 4; ++j) { const f32x4 gp = ((const GAS f32x4*)gpre)[lane + 64 * j]; v[j] = v[j] * rs * gp;
            const unsigned lo = pk2(v[j].x, v[j].y), hi = pk2(v[j].z, v[j].w);
            ((GAS unsigned long long*)xn)[lane + 64 * j] = (unsigned long long)lo | ((unsigned long long)hi << 32);
            v[j].x = __uint_as_float(lo << 16); v[j].y = __uint_as_float(lo & 0xffff0000u); v[j].z = __uint_as_float(hi << 16); v[j].w = __uint_as_float(hi & 0xffff0000u); }
        if (Gr) {
            float mine = 0.f;
#pragma unroll 1
            for (int g = 0; g < 12; ++g) { float d = 0.f;
#pragma unroll
                for (int j = 0; j < 4; ++j) { const f32x4 w = ((const GAS f32x4*)(Wg + g * 1024))[lane + 64 * j]; d += (v[j].x * w.x + v[j].y * w.y) + (v[j].z * w.z + v[j].w * w.w); }
                d = wave_sum(d); if (lane == g) mine = d; }
            if (lane < 16) Gr[lane] = (lane < 12) ? mine : 0.f;
        }
    }
}
DEV float wave_excl_add(float tot, int lane) { float inc = tot;
#pragma unroll
    for (int o = 1; o < 64; o <<= 1) { const float v = __shfl_up(inc, o); if (lane >= o) inc += v; }
    return inc - tot; }
DEV float wave_excl_max(float tot, int lane) { float inc = tot;
#pragma unroll
    for (int o = 1; o < 64; o <<= 1) { const float v = __shfl_up(inc, o); if (lane >= o) inc = fmaxf(inc, v); }
    const float ex = __shfl_up(inc, 1); return lane == 0 ? -INFINITY : ex; }

__constant__ int c_bucket[128] = {0, 1, 2, 3, 4, 5, 6, 7, 8, 9, 10, 11, 12, 13, 14, 15, 16, 16, 16, 17, 17, 18, 18, 18, 19, 19, 19, 20, 20, 20, 20, 21, 21, 21, 21, 22, 22, 22, 22, 22, 23, 23, 23, 23, 23, 23, 24, 24, 24, 24, 24, 24, 25, 25, 25, 25, 25, 25, 25, 26, 26, 26, 26, 26, 26, 26, 26, 27, 27, 27, 27, 27, 27, 27, 27, 27, 27, 28, 28, 28, 28, 28, 28, 28, 28, 28, 28, 29, 29, 29, 29, 29, 29, 29, 29, 29, 29, 29, 29, 30, 30, 30, 30, 30, 30, 30, 30, 30, 30, 30, 30, 30, 30, 31, 31, 31, 31, 31, 31, 31, 31, 31, 31, 31, 31, 31, 31, 31};

struct MixP {
    const bf16* Z; const float* G; bf16* Y;
    float* pw; bf16 *pkk, *pb, *pkm, *pg; bf16* qk; float *fc, *ma, *mMx, *mm;
    const float *mu, *w0, *w_up, *a0, *a_up, *g_up, *k_k, *k_a, *r_k, *ln_w, *ln_b, *cw, *cb, *b_i, *b_f, *mnorm, *sinks, *fox_bf, *rel_bias;
};
DEV void rwkv_scan_unit(const MixP& P, int bh, LAS float* sl, int lane) {
    const int b = bh >> 2, h = bh & 3, c = h * 64 + lane;
    LAS float *sw = sl, *skk = sl + 64, *sb = sl + 128, *sk = sl + 192, *sr = sl + 256;
    float S[64];
#pragma unroll
    for (int k = 0; k < 64; ++k) S[k] = 0.f;
    const float mur = P.mu[c], muv = P.mu[512 + c], rk = P.r_k[c], lw = P.ln_w[c], lb = P.ln_b[c];
    float zr_prev = 0.f, zv_prev = 0.f;
    for (int t = 0; t < T; ++t) {
        const size_t tok = (size_t)b * T + t;
        const float zr = bf2f(P.Z[tok * NZ + c]), zv = bf2f(P.Z[tok * NZ + 512 + c]);
        const float r = zr + mur * (zr_prev - zr), v = zv + muv * (zv_prev - zv);
        zr_prev = zr; zv_prev = zv;
        const float kmod_l = bf2f(P.pkm[tok * 256 + c]);
        sw[lane] = P.pw[tok * 256 + c]; skk[lane] = bf2f(P.pkk[tok * 256 + c]); sb[lane] = bf2f(P.pb[tok * 256 + c]); sk[lane] = kmod_l; sr[lane] = r;
        LDS_WAIT(); asm volatile("" ::: "memory");
        float sa = 0.f;
#pragma unroll
        for (int k = 0; k < 64; ++k) sa -= S[k] * skk[k];
        float yv = 0.f;
#pragma unroll
        for (int k = 0; k < 64; ++k) { S[k] = S[k] * sw[k] + sa * sb[k] + v * sk[k]; yv += S[k] * sr[k]; }
        LDS_WAIT(); asm volatile("" ::: "memory");
        const float mean = wave_sum(yv) * (1.f / 64.f);
        const float dv = yv - mean;
        const float var = wave_sum(dv * dv) * (1.f / 64.f);
        const float yn = dv * rsqrtf(var + 64e-5f) * lw + lb;
        const float bonus = wave_sum(r * kmod_l * rk) * v;
        P.Y[tok * DMIX + c] = (bf16)f2bf((yn + bonus) * bf2f(P.pg[tok * 256 + c]));
    }
}
DEV void mlstm_unit(const MixP& P, int bh, int tb, int lane) {
    const int b = bh >> 2, h = bh & 3, t = tb * 64 + lane; const size_t tok = (size_t)b * T + t;
    float q[32], acc[64];
#pragma unroll
    for (int d = 0; d < 32; ++d) q[d] = bf2f(P.qk[tok * 256 + h * 32 + d]);
#pragma unroll
    for (int d = 0; d < 64; ++d) acc[d] = 0.f;
    float den = 0.f; const float Mx = P.mMx[tok * 4 + h];
    const int smax = tb * 64 + 63;
    for (int s = 0; s <= smax; ++s) {
        const size_t ts = (size_t)b * T + s;
        float dot = 0.f;
#pragma unroll
        for (int d = 0; d < 32; ++d) dot += q[d] * bf2f(P.qk[ts * 256 + 128 + h * 32 + d]);
        const float sc = (s <= t) ? dot * expf(P.ma[ts * 4 + h] - Mx) : 0.f;
        den += sc;
#pragma unroll
        for (int d = 0; d < 64; ++d) acc[d] += sc * bf2f(P.Z[ts * NZ + 1280 + h * 64 + d]);
    }
    const float dn = 1.f / fmaxf(fabsf(den), expf(-P.mm[tok * 4 + h]));
    float ss = 0.f;
#pragma unroll
    for (int d = 0; d < 64; ++d) { acc[d] *= dn; ss += acc[d] * acc[d]; }
    const float rs = rsqrtf(ss * (1.f / 64.f) + NORM_EPS);
#pragma unroll
    for (int d = 0; d < 64; ++d) { const int c = h * 64 + d; P.Y[tok * DMIX + 256 + c] = (bf16)f2bf(acc[d] * rs * P.mnorm[c] * sigmoidf_(bf2f(P.Z[tok * NZ + 1536 + c]))); }
}
DEV void swa_unit(const MixP& P, int bh, int tb, int lane) {
    const int b = bh >> 2, hq = bh & 3, kvh = hq >> 1, t = tb * 64 + lane; const size_t tok = (size_t)b * T + t;
    float q[64], acc[64];
#pragma unroll
    for (int d = 0; d < 64; ++d) { q[d] = bf2f(P.Z[tok * NZ + 1792 + hq * 64 + d]) * 0.125f; acc[d] = 0.f; }
    const float sink = P.sinks[hq];
    float m = sink, l = 1.f;
    for (int dist = 0; dist < 128; ++dist) {
        const int s = t - dist; const bool ok = s >= 0; const size_t ts = (size_t)b * T + (ok ? s : 0);
        float dot = P.rel_bias[c_bucket[dist] * 4 + hq];
#pragma unroll
        for (int d = 0; d < 64; ++d) dot += q[d] * bf2f(P.Z[ts * NZ + 2048 + kvh * 64 + d]);
        if (ok) {
            const float mn = fmaxf(m, dot), f = expf(m - mn), p = expf(dot - mn);
            l = l * f + p; m = mn;
#pragma unroll
            for (int d = 0; d < 64; ++d) acc[d] = acc[d] * f + p * bf2f(P.Z[ts * NZ + 2176 + kvh * 64 + d]);
        }
    }
    const float il = 1.f / l;
#pragma unroll
    for (int d = 0; d < 64; ++d) P.Y[tok * DMIX + 512 + hq * 64 + d] = (bf16)f2bf(acc[d] * il);
}
DEV void fox_unit(const MixP& P, int bh, int tb, int lane) {
    const int b = bh >> 2, h = bh & 3, t = tb * 64 + lane; const size_t tok = (size_t)b * T + t;
    float q[64], acc[64];
#pragma unroll
    for (int d = 0; d < 64; ++d) { q[d] = bf2f(P.Z[tok * NZ + 2304 + h * 64 + d]) * 0.125f; acc[d] = 0.f; }
    float m = -INFINITY, l = 0.f; const float ct = P.fc[tok * 4 + h];
    const int smax = tb * 64 + 63;
    for (int s = 0; s <= smax; ++s) {
        const size_t ts = (size_t)b * T + s;
        float dot = ct - P.fc[ts * 4 + h];
#pragma unroll
        for (int d = 0; d < 64; ++d) dot += q[d] * bf2f(P.Z[ts * NZ + 2560 + h * 64 + d]);
        if (s <= t) {
            const float mn = fmaxf(m, dot), f = expf(m - mn), p = expf(dot - mn);
            l = l * f + p; m = mn;
#pragma unroll
            for (int d = 0; d < 64; ++d) acc[d] = acc[d] * f + p * bf2f(P.Z[ts * NZ + 2816 + h * 64 + d]);
        }
    }
    const float il = 1.f / l;
#pragma unroll
    for (int d = 0; d < 64; ++d) P.Y[tok * DMIX + 768 + h * 64 + d] = (bf16)f2bf(acc[d] * il);
}
DEV void gate_scan_mlstm(const MixP& P, int bh, int lane) {
    const int b = bh >> 2, h = bh & 3; const float bi = P.b_i[h], bf = P.b_f[h];
    float li[32], Fl[32]; float F = 0.f;
#pragma unroll
    for (int j = 0; j < 32; ++j) { const size_t tok = (size_t)b * T + lane * 32 + j;
        const float ip = P.G[tok * 16 + h] + bi, fp = P.G[tok * 16 + 4 + h] + bf;
        li[j] = 15.f * tanhf(ip * (1.f / 15.f)); F += logsigmoidf_(15.f * tanhf(fp * (1.f / 15.f))); Fl[j] = F; }
    const float Fex = wave_excl_add(F, lane);
    float pm = -INFINITY;
#pragma unroll
    for (int j = 0; j < 32; ++j) { Fl[j] += Fex; li[j] = li[j] - Fl[j]; pm = fmaxf(pm, li[j]); }
    float run = wave_excl_max(pm, lane);
#pragma unroll
    for (int j = 0; j < 32; ++j) { const size_t tok = (size_t)b * T + lane * 32 + j; run = fmaxf(run, li[j]); const float Mx = fmaxf(run, 0.f);
        P.ma[tok * 4 + h] = li[j]; P.mMx[tok * 4 + h] = Mx; P.mm[tok * 4 + h] = Fl[j] + Mx; }
}
DEV void gate_scan_fox(const MixP& P, int bh, int lane) {
    const int b = bh >> 2, h = bh & 3; const float bf = P.fox_bf[h];
    float cl[32]; float c = 0.f;
#pragma unroll
    for (int j = 0; j < 32; ++j) { const size_t tok = (size_t)b * T + lane * 32 + j; c += logsigmoidf_(P.G[tok * 16 + 8 + h] + bf); cl[j] = c; }
    const float ex = wave_excl_add(c, lane);
#pragma unroll
    for (int j = 0; j < 32; ++j) { const size_t tok = (size_t)b * T + lane * 32 + j; P.fc[tok * 4 + h] = cl[j] + ex; }
}

struct Args { const float* in[30]; float* out; unsigned char* ws; int ph_lo, ph_hi, li, pad; };
template <int l> DEV void layer_body(const Args& args, LAS unsigned char* L, const XcdBarrier& bar, const int tid, const int lane, const int wave, const int G, const int bx, const int gw, const int NGW, gu32* ctl) {
    unsigned char* ws = args.ws;
    const int lo = args.ph_lo, hi = args.ph_hi;
#define IN(k) (lo <= (k) && (k) < hi)
#define SEAM(k) do { if (IN(k) && IN((k) + 1)) { if (MK_PER_PHASE) { if (tid == 0) __hip_atomic_store(ctl + CW_TMO, 0xBADBA0u, RLX_AGENT); } else xcd_barrier(bar); } } while (0)

    bf16* Win_t = (bf16*)(ws + WS_WIN); bf16* Wout_t = (bf16*)(ws + WS_WOUT); bf16* Wup_t = (bf16*)(ws + WS_WUP); bf16* Wdn_t = (bf16*)(ws + WS_WDN);
    float* Wg = (float*)(ws + WS_WG);
    bf16* XN = (bf16*)(ws + WS_XN); bf16* Z = (bf16*)(ws + WS_Z); bf16* Y = (bf16*)(ws + WS_Y);
    float* O = (float*)(ws + WS_O); bf16* GATE = (bf16*)(ws + WS_GATE); bf16* UP = (bf16*)(ws + WS_UP); float* O2 = (float*)(ws + WS_O2);
    float* Gg = (float*)(ws + WS_MISC);
    float* X = args.out;


        const int pb = l * PH_PER_LAYER;
        const float* w_in = args.in[1] + (size_t)l * D * NIN; const float* w_out = args.in[2] + (size_t)l * DMIX * D;
        const float* g_mix_pre = args.in[3] + l * D; const float* g_mix_post = args.in[4] + l * D; const float* g_ffn_pre = args.in[5] + l * D; const float* g_ffn_post = args.in[6] + l * D;
        const float* w_up = args.in[26] + (size_t)l * D * NUP; const float* fcw = args.in[27] + (size_t)l * 3 * DFF; const float* fcb = args.in[28] + (size_t)l * DFF; const float* w_dn = args.in[29] + (size_t)l * DFF * D;
        MixP P;
        P.Z = Z; P.G = Gg; P.Y = Y; P.pw = (float*)(ws + WS_PW); P.pkk = (bf16*)(ws + WS_PKK); P.pb = (bf16*)(ws + WS_PB); P.pkm = (bf16*)(ws + WS_PKM); P.pg = (bf16*)(ws + WS_PG); P.qk = (bf16*)(ws + WS_QK);
        P.fc = Gg + (size_t)M * 16; P.ma = P.fc + (size_t)M * 4; P.mMx = P.ma + (size_t)M * 4; P.mm = P.mMx + (size_t)M * 4;
        P.mu = args.in[7] + l * 1024; P.w0 = args.in[8] + l * 256; P.w_up = args.in[9] + l * 64 * 256; P.a0 = args.in[10] + l * 256; P.a_up = args.in[11] + l * 64 * 256; P.g_up = args.in[12] + l * 128 * 256;
        P.k_k = args.in[13] + l * 256; P.k_a = args.in[14] + l * 256; P.r_k = args.in[15] + l * 256; P.ln_w = args.in[16] + l * 256; P.ln_b = args.in[17] + l * 256;
        P.cw = args.in[18] + l * 4 * 256; P.cb = args.in[19] + l * 256; P.b_i = args.in[20] + l * 4; P.b_f = args.in[21] + l * 4; P.mnorm = args.in[22] + l * 256; P.sinks = args.in[23] + l * 4; P.fox_bf = args.in[24] + l * 4; P.rel_bias = args.in[25];

        if (IN(pb + 0)) {
            LAS float* scr = (LAS float*)(L + RING_OFF + wave * 16384);
            constexpr int I_A = 16 * 56, I_B = 16 * 40, I_O = 16 * 32, I_U = 16 * 176, I_D = 44 * 32, NITEMS = I_A + I_B + I_O + I_U + I_D;
            for (int it = gw; it < NITEMS; it += NGW) {
                int r = it;
                if (r < I_A) { p0_transpose_item(w_in, NIN, 0, 1792, Win_t, D, 0, scr, r, lane); continue; } r -= I_A;
                if (r < I_B) { p0_transpose_item(w_in, NIN, 1800, 1280, Win_t, D, 1792, scr, r, lane); continue; } r -= I_B;
                if (r < I_O) { p0_transpose_item(w_out, D, 0, D, Wout_t, DMIX, 0, scr, r, lane); continue; } r -= I_O;
                if (r < I_U) { p0_transpose_item(w_up, NUP, 0, NUP, Wup_t, D, 0, scr, r, lane); continue; } r -= I_U;
                p0_transpose_item(w_dn, D, 0, D, Wdn_t, DFF, 0, scr, r, lane);
            }
            for (int i = bx * 512 + tid; i < 16 * 1024; i += G * 512) { const int g = i >> 10, k = i & 1023; const int col = g < 4 ? 1792 + g : (g < 8 ? 1796 + (g - 4) : 3080 + (g - 8)); Wg[i] = g < 12 ? w_in[(size_t)k * NIN + col] : 0.f; }
            if (l == 0) {
                for (int m = gw; m < M; m += NGW) norm_row(args.in[0] + (size_t)m * D, nullptr, nullptr, X + (size_t)m * D, g_mix_pre, XN + (size_t)m * D, nullptr, nullptr, lane);
            }
        }
        SEAM(pb + 0);
        if (IN(pb + 1)) {
            {
                pg8::Gemm g{XN, Win_t, M, NZ, D}; pg8::StaticOrder S; S.init(M, NZ, G, bx);
                pg8::EpiBf16<0> E{Z, NZ, nullptr, 0, 0, 1.f};
                pg8::gemm_phase<pg8::EpiBf16<0>, pg8::StaticOrder, true, true>(L + RING_OFF, g, S, E);
            }
            for (int m = gw; m < M; m += NGW) {
                f32x4 v[4];
#pragma unroll
                for (int j = 0; j < 4; ++j) { const unsigned long long p = ((const GAS unsigned long long*)(XN + (size_t)m * D))[lane + 64 * j]; const unsigned lo_ = (unsigned)p, hi_ = (unsigned)(p >> 32);
                    v[j].x = __uint_as_float(lo_ << 16); v[j].y = __uint_as_float(lo_ & 0xffff0000u); v[j].z = __uint_as_float(hi_ << 16); v[j].w = __uint_as_float(hi_ & 0xffff0000u); }
                float mine = 0.f;
#pragma unroll 1
                for (int g = 0; g < 12; ++g) { float d = 0.f;
#pragma unroll
                    for (int j = 0; j < 4; ++j) { const f32x4 w = ((const GAS f32x4*)(Wg + g * 1024))[lane + 64 * j]; d += (v[j].x * w.x + v[j].y * w.y) + (v[j].z * w.z + v[j].w * w.w); }
                    d = wave_sum(d); if (lane == g) mine = d; }
                if (lane < 16) Gg[(size_t)m * 16 + lane] = (lane < 12) ? mine : 0.f;
            }
        }
        SEAM(pb + 1);
        if (IN(pb + 2)) {
            LAS float* zs = (LAS float*)(L + RING_OFF);
            const int half = tid >> 8, c = tid & 255;
            for (int it = bx; it < M / 2; it += G) {
                const int tok = it * 2 + half, t = tok % T;
                __syncthreads();
#pragma unroll
                for (int j = 0; j < 4; ++j) { const int col = c + 256 * j; const float cur = bf2f(Z[(size_t)tok * NZ + col]); const float prv = t > 0 ? bf2f(Z[(size_t)(tok - 1) * NZ + col]) : 0.f; zs[half * 1024 + col] = cur + P.mu[col] * (prv - cur); }
                __syncthreads();
                const LAS float* z1 = zs + half * 1024;
                float wp = P.w0[c], ap = P.a0[c], gp = 0.f;
                for (int j = 0; j < 64; ++j) { wp += tanhf(z1[768 + j]) * P.w_up[j * 256 + c]; ap += z1[832 + j] * P.a_up[j * 256 + c]; }
                for (int j = 0; j < 128; ++j) gp += sigmoidf_(z1[896 + j]) * P.g_up[j * 256 + c];
                const float w = expf(-expf(-softplusf_(-wp) - 0.5f));
                const float a = sigmoidf_(ap);
                const float kraw = z1[256 + c];
                const float kkp = kraw * P.k_k[c];
                const float nrm = sqrtf(wave_sum(kkp * kkp));
                const float kk = kkp / fmaxf(nrm, 1e-12f);
                const float kmod = kraw * (1.f + (a - 1.f) * P.k_a[c]);
                P.pw[(size_t)tok * 256 + c] = w; P.pkk[(size_t)tok * 256 + c] = (bf16)f2bf(kk); P.pb[(size_t)tok * 256 + c] = (bf16)f2bf(kk * a); P.pkm[(size_t)tok * 256 + c] = (bf16)f2bf(kmod); P.pg[(size_t)tok * 256 + c] = (bf16)f2bf(gp);
            }
            for (int i = bx * 512 + tid; i < M * 256; i += G * 512) {
                const int tok = i >> 8, c2 = i & 255, t = tok % T;
                float s = P.cb[c2];
#pragma unroll
                for (int j = 0; j < 4; ++j) { const int tt = t - 3 + j; if (tt >= 0) s += P.cw[j * 256 + c2] * bf2f(Z[(size_t)(tok - 3 + j) * NZ + 1024 + c2]); }
                s = s * sigmoidf_(s);
                if (c2 < 128) s *= 0.17677669529663687f;
                P.qk[i] = (bf16)f2bf(s);
            }
            if (wave == 1 && bx < 64) { if (bx < 32) gate_scan_mlstm(P, bx, lane); else gate_scan_fox(P, bx - 32, lane); }
        }
        SEAM(pb + 2);
        if (IN(pb + 3)) {
            if (wave == 0 && bx < 32) rwkv_scan_unit(P, bx, (LAS float*)(L + RING_OFF), lane);
            for (int u = gw; u < 3 * 1024; u += NGW) {
                const int kind = u >> 10, rem = u & 1023, tb = 31 - (rem >> 5), bh = rem & 31;
                if (kind == 0) fox_unit(P, bh, tb, lane); else if (kind == 1) mlstm_unit(P, bh, tb, lane); else swa_unit(P, bh, tb, lane);
            }
        }
        SEAM(pb + 3);
        if (IN(pb + 4)) {
            pg8::Gemm g{Y, Wout_t, M, D, DMIX}; pg8::StaticOrder S; S.init(M, D, G, bx);
            pg8::EpiF32 E{O, D};
            pg8::gemm_phase<pg8::EpiF32, pg8::StaticOrder, true, true>(L + RING_OFF, g, S, E);
        }
        SEAM(pb + 4);
        if (IN(pb + 5)) {
            for (int m = gw; m < M; m += NGW) norm_row(X + (size_t)m * D, O + (size_t)m * D, g_mix_post, X + (size_t)m * D, g_ffn_pre, XN + (size_t)m * D, nullptr, nullptr, lane);
        }
        SEAM(pb + 5);
        if (IN(pb + 6)) {
            pg8::Gemm g{XN, Wup_t, M, NUP, D}; pg8::StaticOrder S; S.init(M, NUP, G, bx);
            pg8::EpiBf16<0> E{GATE, DFF, nullptr, DFF, (size_t)(WS_UP - WS_GATE) / 2, 1.f};
            pg8::gemm_phase<pg8::EpiBf16<0>, pg8::StaticOrder, true, true>(L + RING_OFF, g, S, E);
        }
        SEAM(pb + 6);
        if (IN(pb + 7)) {
            for (int tok = bx; tok < M; tok += G) {
                const int t = tok % T;
                for (int c = tid; c < DFF; c += 512) {
                    float gv = fcb[c] + fcw[2 * DFF + c] * bf2f(GATE[(size_t)tok * DFF + c]);
                    if (t >= 1) gv += fcw[1 * DFF + c] * bf2f(GATE[(size_t)(tok - 1) * DFF + c]);
                    if (t >= 2) gv += fcw[0 * DFF + c] * bf2f(GATE[(size_t)(tok - 2) * DFF + c]);
                    const float ge = 0.5f * gv * (1.f + tanhf(0.7978845608028654f * (gv + 0.044715f * gv * gv * gv)));
                    UP[(size_t)tok * DFF + c] = (bf16)f2bf(ge * bf2f(UP[(size_t)tok * DFF + c]));
                }
            }
        }
        SEAM(pb + 7);
        if (IN(pb + 8)) {
            pg8::Gemm g{UP, Wdn_t, M, D, DFF}; pg8::StaticOrder S; S.init(M, D, G, bx);
            pg8::EpiF32 E{O2, D};
            pg8::gemm_phase<pg8::EpiF32, pg8::StaticOrder, true, true>(L + RING_OFF, g, S, E);
        }
        SEAM(pb + 8);
        if (IN(pb + 9)) {
            const float* gnext = args.in[3] + D;
            for (int m = gw; m < M; m += NGW) norm_row(X + (size_t)m * D, O2 + (size_t)m * D, g_ffn_post, X + (size_t)m * D, gnext, l == 0 ? XN + (size_t)m * D : nullptr, nullptr, nullptr, lane);
        }
        SEAM(pb + 9);

#undef IN
#undef SEAM
}
__global__ void __launch_bounds__(NWAVES * 64, 2) mk_fwd(Args args) {
    extern __shared__ __attribute__((aligned(16))) unsigned char lds[];
    LAS unsigned char* L = (LAS unsigned char*)lds;
    volatile LAS unsigned* MISC = (volatile LAS unsigned*)(L + MISC_OFF);
    const int tid = threadIdx.x, lane = tid & 63, wave = __builtin_amdgcn_readfirstlane(tid >> 6);
    const int G = gridDim.x, bx = blockIdx.x;
    const int vcu = (G % 8 == 0) ? (bx % 8) * (G / 8) + bx / 8 : bx;
    const int gw = vcu * NWAVES + wave, NGW = G * NWAVES;
    unsigned char* ws = args.ws;
    gu32* ctl = (gu32*)(ws + WS_CTL);
    for (int u = tid; u < (LDS_BYTES - LDSCTL_OFF) / 4; u += NWAVES * 64) ((LAS unsigned*)(L + LDSCTL_OFF))[u] = 0u;
    __syncthreads();
    XcdBarrier bar; bar.bar = (unsigned*)(ctl + CW_BAR); bar.x = 0; bar.st = nullptr;
    if (!MK_PER_PHASE) bar = xcd_barrier_post((unsigned*)(ctl + CW_BAR), MISC + 8);
    layer_body<0>(args, L, bar, tid, lane, wave, G, bx, gw, NGW, ctl);
    layer_body<1>(args, L, bar, tid, lane, wave, G, bx, gw, NGW, ctl);
}

extern "C" void kernel_launch(void* const* d_in, const int* in_sizes, int n_in, void* d_out, int out_size, void* d_ws, size_t ws_size, hipStream_t stream) {
    static int grid = 0;
    if (grid == 0) {
        if (n_in != 30 || out_size != M * D || ws_size < WS_END) { fprintf(stderr, "kernel_launch: unexpected shapes (n_in %d out %d ws %zu)\n", n_in, out_size, ws_size); grid = -1; return; }
        int dev = 0, cus = 0, per_cu = 0;
        if (hipGetDevice(&dev) != hipSuccess || hipDeviceGetAttribute(&cus, hipDeviceAttributeMultiprocessorCount, dev) != hipSuccess) { grid = -1; return; }
        if (hipFuncSetAttribute((const void*)mk_fwd, hipFuncAttributeMaxDynamicSharedMemorySize, LDS_BYTES) != hipSuccess) { fprintf(stderr, "kernel_launch: hipFuncSetAttribute failed\n"); grid = -1; return; }
        if (hipOccupancyMaxActiveBlocksPerMultiprocessor(&per_cu, (const void*)mk_fwd, NWAVES * 64, LDS_BYTES) != hipSuccess || per_cu < 1) { fprintf(stderr, "kernel_launch: occupancy query says %d blocks/CU\n", per_cu); }
        (void)hipGetLastError();
        grid = cus;
    }
    if (grid < 0) return;
    if (hipMemsetAsync((char*)d_ws + WS_CTL, 0, CTL_ZERO_BYTES, stream) != hipSuccess) return;
    Args a{};
    for (int i = 0; i < 30; ++i) a.in[i] = (const float*)d_in[i];
    a.out = (float*)d_out; a.ws = (unsigned char*)d_ws;
#if MK_PER_PHASE
    for (int p = 0; p < N_PHASES; ++p) { a.ph_lo = p; a.ph_hi = p + 1; a.li = p; hipLaunchKernelGGL(mk_fwd, dim3(grid), dim3(NWAVES * 64), LDS_BYTES, stream, a); }
#else
    a.ph_lo = 0; a.ph_hi = N_PHASES; a.li = 0;
    hipLaunchKernelGGL(mk_fwd, dim3(grid), dim3(NWAVES * 64), LDS_BYTES, stream, a);
#endif
}
```

```cpp
#include <hip/hip_runtime.h>
#include <cstdio>
#include <cstdint>
#include <cmath>
namespace pg8 {
#define PG8_LAS __attribute__((address_space(3)))
typedef unsigned short bf16_t;
typedef short bf16x8 __attribute__((ext_vector_type(8)));
typedef float f32x4 __attribute__((ext_vector_type(4)));
typedef unsigned u32x4 __attribute__((ext_vector_type(4)));
constexpr int BM = 256, BK = 64, HALF = 128, HTB = HALF * BK * 2  , STAGE_BYTES = 8 * HTB, NXCD = 8, WGM = 8;

__host__ __device__ __forceinline__ int lds_byte(int r, int c) { const int st = (r >> 4) * 2 + (c >> 5), rr = r & 15, cc = c & 31, ob = rr * 64 + cc * 2; return st * 1024 + (ob ^ (((ob >> 9) & 1) << 5)); }
__host__ __device__ __forceinline__ void stage_rc(int b, int& R, int& C) { const int st = b / 1024, sb = b % 1024, swz = sb ^ (((sb >> 9) & 1) << 5); R = (st >> 1) * 16 + swz / 64; C = (st & 1) * 32 + (swz % 64) / 2; }
__host__ __device__ __forceinline__ int perm32(int rho) { const int n = rho >> 4, i = rho & 15; return 8 * (i >> 2) + 4 * n + (i & 3); }

struct Unit { int pm, pn; };
struct Gemm { const bf16_t* A; const bf16_t* Bt; int M, N, K; };

struct StaticOrder {
    int nM, nN, nwg, G, c;
    __host__ __device__ void init(int M, int N, int G_, int c_) { nM = M / BM; nN = N / BM; nwg = nM * nN; G = G_; c = c_; }
    __host__ __device__ bool next(int i, Unit& u) const {
        const long L = (long)i * G + c; if (L >= nwg) return false;
        int wgid = (int)L; { const int q = nwg / NXCD, r = nwg % NXCD, xcd = wgid % NXCD, off = wgid / NXCD; wgid = (xcd < r ? xcd * (q + 1) : r * (q + 1) + (xcd - r) * q) + off; }
        const int nig = WGM * nN, gid = wgid / nig, fm = gid * WGM, gsz = (nM - fm) < WGM ? (nM - fm) : WGM;
        u.pm = fm + ((wgid % nig) % gsz); u.pn = (wgid % nig) / gsz; return true;
    }
    __device__ __forceinline__ void a_ready(const Unit&) const {}
    __device__ __forceinline__ void done(const Unit&) const {}
};

__device__ __forceinline__ unsigned cvt_pk_bf16(float lo, float hi) { unsigned r; asm volatile("v_cvt_pk_bf16_f32 %0, %1, %2" : "=v"(r) : "v"(lo), "v"(hi)); return r; }
typedef float f32x2 __attribute__((ext_vector_type(2)));
__device__ __forceinline__ f32x2 gelu_pk(f32x2 v) {
    const f32x2 av = __builtin_elementwise_abs(v), d = av * 0.2316418882f + 1.0f;
    f32x2 t; t.x = __builtin_amdgcn_rcpf(d.x); t.y = __builtin_amdgcn_rcpf(d.y);
    f32x2 q = t * 0.5307027145f + (-0.7265760135f); q = q * t + 0.7107068705f; q = q * t + (-0.142248368f); q = q * t + 0.127414796f; q = q * t;
    const f32x2 s = (v * v) * (-0.72134752044f);
    f32x2 e; e.x = __builtin_amdgcn_exp2f(s.x); e.y = __builtin_amdgcn_exp2f(s.y);
    const f32x2 m = v * (q * e), r = v - m;
    f32x2 o; o.x = v.x < 0.f ? m.x : r.x; o.y = v.y < 0.f ? m.y : r.y; return o;
}

template <int ACT  > struct EpiBf16 {
    static constexpr bool PERM = true, AFTER_DRAIN = false; static_assert(ACT == 0 || ACT == 1, "EpiBf16: ACT is 0 (none) or 1 (gelu_pk)");
    bf16_t* O; int ldc; const float* bias; int split_cols; size_t split_stride; float scale0;
    __device__ __forceinline__ void operator()(const f32x4 (&acc)[2][2][4][2], const Unit& u, int wr, int wc, int fr, int fq) const {
        const int row0 = u.pm * BM + wr * 64 + fr; int colt = u.pn * BM; bf16_t* base = O;
        float sc = 1.f; if (split_cols) { const int t = colt / split_cols; base += (size_t)t * split_stride; colt -= t * split_cols; if (t == 0) sc = scale0; }
        const int col0 = colt + wc * 32 + 8 * fq, bcol0 = u.pn * BM + wc * 32 + 8 * fq;
        f32x4 bv[2][2];
#pragma unroll
        for (int bj = 0; bj < 2; ++bj)
#pragma unroll
            for (int n = 0; n < 2; ++n) bv[bj][n] = bias ? *(const f32x4*)(bias + bcol0 + bj * HALF + 4 * n) : (f32x4){0.f, 0.f, 0.f, 0.f};
#pragma unroll
        for (int ai = 0; ai < 2; ++ai)
#pragma unroll
            for (int m = 0; m < 4; ++m) { bf16_t* rowp = base + (size_t)(row0 + ai * HALF + m * 16) * ldc + col0;
#pragma unroll
                for (int bj = 0; bj < 2; ++bj) { f32x4 v0 = acc[ai][bj][m][0] + bv[bj][0], v1 = acc[ai][bj][m][1] + bv[bj][1];
                    if (ACT == 1) { f32x2 a = gelu_pk((f32x2){v0[0], v0[1]}), b = gelu_pk((f32x2){v0[2], v0[3]}), c = gelu_pk((f32x2){v1[0], v1[1]}), d = gelu_pk((f32x2){v1[2], v1[3]});
                        v0 = (f32x4){a.x, a.y, b.x, b.y}; v1 = (f32x4){c.x, c.y, d.x, d.y}; }
                    v0 = v0 * sc; v1 = v1 * sc; u32x4 w; w.x = cvt_pk_bf16(v0[0], v0[1]); w.y = cvt_pk_bf16(v0[2], v0[3]); w.z = cvt_pk_bf16(v1[0], v1[1]); w.w = cvt_pk_bf16(v1[2], v1[3]);
                    *(u32x4*)(rowp + bj * HALF) = w; } }
    }
};
struct EpiF32 {
    static constexpr bool PERM = false, AFTER_DRAIN = false;
    float* C; int ldc;
    __device__ __forceinline__ void operator()(const f32x4 (&acc)[2][2][4][2], const Unit& u, int wr, int wc, int fr, int fq) const {
        const int row0 = u.pm * BM + wr * 64 + fr, col0 = u.pn * BM + wc * 32 + 4 * fq;
#pragma unroll
        for (int ai = 0; ai < 2; ++ai)
#pragma unroll
            for (int m = 0; m < 4; ++m) { float* rowp = C + (size_t)(row0 + ai * HALF + m * 16) * ldc + col0;
#pragma unroll
                for (int bj = 0; bj < 2; ++bj)
#pragma unroll
                    for (int n = 0; n < 2; ++n) *(f32x4*)(rowp + bj * HALF + n * 16) = acc[ai][bj][m][n]; }
    }
};
template <class Epi, class Sched, bool ALIGN_EPI = false, bool SP2 = false>
__device__ __forceinline__ void gemm_phase(PG8_LAS unsigned char* lds, const Gemm g, const Sched& S, const Epi& E) {
    const int tid = threadIdx.x, wid = __builtin_amdgcn_readfirstlane(tid >> 6), lane = tid & 63, wr = wid >> 2, wc = wid & 3, fr = lane & 15, fq = lane >> 4;
    const int K = g.K, nt = K / BK;
    unsigned voffA[2], voffB[2];
#pragma unroll
    for (int i = 0; i < 2; ++i) { int R, C; stage_rc(tid * 16 + i * 8192, R, C); const int Rb = Epi::PERM ? ((R & ~31) + perm32(R & 31)) : R;
        voffA[i] = (unsigned)(R * K + C) * 2u; voffB[i] = (unsigned)(Rb * K + C) * 2u; }
    const size_t kstep = (size_t)(BK * 2);
    const size_t hstep = (size_t)HALF * K * 2;
    const size_t tstep = 2 * hstep;
    const unsigned ldsw = (unsigned)wid * 1024u;
    const int aoff = lds_byte(wr * 64 + fr, fq * 8), boff = lds_byte(wc * 32 + fr, fq * 8);
#define PG8_SA(b, h) (((b) * 2 + (h)) * HTB)
#define PG8_SB(b, h) ((4 + (b) * 2 + (h)) * HTB)
#define PG8_STAGE(bufoff, gbase, voff) do { _Pragma("unroll") for (int _i = 0; _i < 2; ++_i) \
        __builtin_amdgcn_global_load_lds((const unsigned*)((const char*)(gbase) + (voff)[_i]), (PG8_LAS unsigned*)(lds + (bufoff) + ldsw + _i * 8192), 16, 0, 0); } while (0)
#define PG8_LDA(dst, b, h) do { _Pragma("unroll") for (int m = 0; m < 4; ++m) _Pragma("unroll") for (int k = 0; k < 2; ++k) dst[m][k] = *(const PG8_LAS bf16x8*)(lds + PG8_SA(b, h) + aoff + m * 2048 + k * 1024); } while (0)
#define PG8_LDB(dst, b, h) do { _Pragma("unroll") for (int n = 0; n < 2; ++n) _Pragma("unroll") for (int k = 0; k < 2; ++k) dst[n][k] = *(const PG8_LAS bf16x8*)(lds + PG8_SB(b, h) + boff + n * 2048 + k * 1024); } while (0)
#define PG8_MMA(ai, bj, At, Bt) do { __builtin_amdgcn_s_setprio(1); _Pragma("unroll") for (int m = 0; m < 4; ++m) _Pragma("unroll") for (int n = 0; n < 2; ++n) _Pragma("unroll") for (int k = 0; k < 2; ++k) \
        acc[ai][bj][m][n] = __builtin_amdgcn_mfma_f32_16x16x32_bf16(Bt[n][k], At[m][k], acc[ai][bj][m][n], 0, 0, 0); __builtin_amdgcn_s_setprio(0); } while (0)
#define PG8_WAIT_V(n) asm volatile("s_waitcnt vmcnt(" #n ")" ::: "memory")
#define PG8_WAIT_L(n) asm volatile("s_waitcnt lgkmcnt(" #n ")" ::: "memory")
#define PG8_BAR __builtin_amdgcn_s_barrier()
#define PG8_SCHED __builtin_amdgcn_sched_barrier(0)
    Unit cur, nxt; int ui = 0;
    if (!S.next(0, cur)) return;
    f32x4 acc[2][2][4][2];
#pragma unroll
    for (int a = 0; a < 2; ++a)
#pragma unroll
        for (int b = 0; b < 2; ++b)
#pragma unroll
            for (int m = 0; m < 4; ++m)
#pragma unroll
                for (int n = 0; n < 2; ++n) acc[a][b][m][n] = (f32x4){0.f, 0.f, 0.f, 0.f};
    bf16x8 At[4][2], B0[2][2], B1[2][2];
    const char* cA = (const char*)g.A + (size_t)cur.pm * tstep; const char* cB = (const char*)g.Bt + (size_t)cur.pn * tstep;
    S.a_ready(cur);
    if constexpr (SP2) {
        PG8_STAGE(PG8_SB(0, 0), cB, voffB); PG8_STAGE(PG8_SB(0, 1), cB + hstep, voffB); PG8_STAGE(PG8_SA(0, 0), cA, voffA); PG8_STAGE(PG8_SA(0, 1), cA + hstep, voffA);
        if (wr == 1) PG8_BAR;
        PG8_WAIT_V(2); PG8_BAR;
        PG8_STAGE(PG8_SB(1, 0), cB + kstep, voffB); PG8_STAGE(PG8_SA(1, 0), cA + kstep, voffA); PG8_STAGE(PG8_SB(1, 1), cB + hstep + kstep, voffB);
        PG8_WAIT_V(6); PG8_BAR;
    } else {
        PG8_STAGE(PG8_SB(0, 0), cB, voffB); PG8_STAGE(PG8_SA(0, 0), cA, voffA); PG8_STAGE(PG8_SB(0, 1), cB + hstep, voffB); PG8_STAGE(PG8_SA(0, 1), cA + hstep, voffA);
        if (wr == 1) PG8_BAR;
        PG8_WAIT_V(4); PG8_BAR;
        PG8_STAGE(PG8_SB(1, 0), cB + kstep, voffB); PG8_STAGE(PG8_SA(1, 0), cA + kstep, voffA); PG8_STAGE(PG8_SB(1, 1), cB + hstep + kstep, voffB);
        PG8_WAIT_V(6); PG8_BAR;
    }
    for (;;) {
        const bool has_next = S.next(ui + 1, nxt);
        const char* nA = has_next ? (const char*)g.A + (size_t)nxt.pm * tstep : cA; const char* nB = has_next ? (const char*)g.Bt + (size_t)nxt.pn * tstep : cB;
        for (int t = 0; t < nt; t += 2) {
            const bool last = (t == nt - 2);
            const char* a1 = cA + (size_t)(t + 1) * kstep;
            const char* a2 = last ? nA : cA + (size_t)(t + 2) * kstep; const char* b2 = last ? nB : cB + (size_t)(t + 2) * kstep;
            const char* a3 = a2 + kstep; const char* b3 = b2 + kstep;
            if (last && has_next) S.a_ready(nxt);
            if constexpr (SP2) {
            PG8_LDB(B0, 0, 0); PG8_LDB(B1, 0, 1); PG8_SCHED; PG8_LDA(At, 0, 0); PG8_STAGE(PG8_SA(1, 1), a1 + hstep, voffA);
            PG8_WAIT_V(8); PG8_WAIT_L(0); PG8_BAR; PG8_MMA(0, 0, At, B0); PG8_MMA(0, 1, At, B1); PG8_BAR; PG8_SCHED;
            PG8_LDA(At, 0, 1); PG8_STAGE(PG8_SB(0, 0), b2, voffB); PG8_STAGE(PG8_SB(0, 1), b2 + hstep, voffB); PG8_STAGE(PG8_SA(0, 0), a2, voffA);
            PG8_WAIT_V(8); PG8_WAIT_L(0); PG8_BAR; PG8_MMA(1, 0, At, B0); PG8_MMA(1, 1, At, B1); PG8_BAR; PG8_SCHED;
            PG8_LDB(B0, 1, 0); PG8_LDB(B1, 1, 1); PG8_SCHED; PG8_LDA(At, 1, 0); PG8_STAGE(PG8_SA(0, 1), a2 + hstep, voffA);
            PG8_WAIT_V(8); PG8_WAIT_L(0); PG8_BAR; PG8_MMA(0, 0, At, B0); PG8_MMA(0, 1, At, B1); PG8_BAR; PG8_SCHED;
            PG8_LDA(At, 1, 1); PG8_STAGE(PG8_SB(1, 0), b3, voffB); PG8_STAGE(PG8_SB(1, 1), b3 + hstep, voffB); PG8_STAGE(PG8_SA(1, 0), a3, voffA);
            PG8_WAIT_V(8); PG8_WAIT_L(0); PG8_BAR; PG8_MMA(1, 0, At, B0); PG8_MMA(1, 1, At, B1); PG8_BAR; PG8_SCHED;
            } else {
            PG8_LDB(B0, 0, 0); PG8_SCHED; PG8_LDA(At, 0, 0); PG8_STAGE(PG8_SA(1, 1), a1 + hstep, voffA);
            PG8_WAIT_L(8); PG8_BAR; PG8_WAIT_L(0); PG8_MMA(0, 0, At, B0); PG8_BAR; PG8_SCHED;
            PG8_LDB(B1, 0, 1); PG8_STAGE(PG8_SB(0, 0), b2, voffB);
            PG8_BAR; PG8_WAIT_L(0); PG8_MMA(0, 1, At, B1); PG8_BAR;
            PG8_LDA(At, 0, 1); PG8_STAGE(PG8_SA(0, 0), a2, voffA);
            PG8_BAR; PG8_WAIT_L(0); PG8_MMA(1, 0, At, B0); PG8_BAR; PG8_SCHED;
            PG8_STAGE(PG8_SB(0, 1), b2 + hstep, voffB);
            PG8_WAIT_V(6); PG8_BAR; PG8_MMA(1, 1, At, B1); PG8_BAR;
            PG8_LDB(B0, 1, 0); PG8_SCHED; PG8_LDA(At, 1, 0); PG8_STAGE(PG8_SA(0, 1), a2 + hstep, voffA);
            PG8_WAIT_L(8); PG8_BAR; PG8_WAIT_L(0); PG8_MMA(0, 0, At, B0); PG8_BAR; PG8_SCHED;
            PG8_LDB(B1, 1, 1); PG8_STAGE(PG8_SB(1, 0), b3, voffB);
            PG8_BAR; PG8_WAIT_L(0); PG8_MMA(0, 1, At, B1); PG8_BAR;
            PG8_LDA(At, 1, 1); PG8_STAGE(PG8_SA(1, 0), a3, voffA);
            PG8_BAR; PG8_WAIT_L(0); PG8_MMA(1, 0, At, B0); PG8_BAR; PG8_SCHED;
            PG8_STAGE(PG8_SB(1, 1), b3 + hstep, voffB);
            PG8_WAIT_V(6); PG8_BAR; PG8_MMA(1, 1, At, B1); PG8_BAR;
            }
        }
        if constexpr (ALIGN_EPI) { if (wr == 0) PG8_BAR; }
        if constexpr (!Epi::AFTER_DRAIN) { E(acc, cur, wr, wc, fr, fq); S.done(cur); }
        if (!has_next) break;
#pragma unroll
        for (int a = 0; a < 2; ++a)
#pragma unroll
            for (int b = 0; b < 2; ++b)
#pragma unroll
                for (int m = 0; m < 4; ++m)
#pragma unroll
                    for (int n = 0; n < 2; ++n) acc[a][b][m][n] = (f32x4){0.f, 0.f, 0.f, 0.f};
        cur = nxt; cA = nA; cB = nB; ++ui;
        if constexpr (ALIGN_EPI) { if (wr == 1) PG8_BAR; }
    }
    PG8_WAIT_V(0);
    if constexpr (!ALIGN_EPI) { if (wr == 0) PG8_BAR; }
    PG8_BAR;
    if constexpr (Epi::AFTER_DRAIN) { E.fused(acc, cur, wr, wc, fr, fq, lds, wid, lane); S.done(cur); }
#undef PG8_SA
#undef PG8_SB
#undef PG8_STAGE
#undef PG8_LDA
#undef PG8_LDB
#undef PG8_MMA
#undef PG8_WAIT_V
#undef PG8_WAIT_L
#undef PG8_BAR
#undef PG8_SCHED
}
}
constexpr int NWAVES = 8;
#ifndef MK_PER_PHASE
#define MK_PER_PHASE 0
#endif
constexpr int BATCH = 8, T = 2048, M = BATCH * T, D = 1024, NIN = 3084, NZ = 3072, DMIX = 1024, DFF = 2816, NUP = 2 * DFF;
constexpr float NORM_EPS = 1e-6f;
constexpr int PH_PER_LAYER = 12, N_PHASES = 2 * PH_PER_LAYER;

constexpr size_t MiB = 1u << 20;
constexpr size_t WS_CTL = 0, CTL_ZERO_BYTES = 1 * MiB;
constexpr size_t WS_WIN = 1 * MiB;
constexpr size_t WS_WOUT = 7 * MiB;
constexpr size_t WS_WUP = 9 * MiB;
constexpr size_t WS_WDN = 20 * MiB;
constexpr size_t WS_WG = 26 * MiB;
constexpr size_t WS_XN = 27 * MiB;
constexpr size_t WS_R = 59 * MiB;
constexpr size_t WS_Z = WS_R;
constexpr size_t WS_Y = WS_R + 96 * MiB;
constexpr size_t WS_PW = WS_R + 128 * MiB;
constexpr size_t WS_PKK = WS_PW + 16 * MiB;
constexpr size_t WS_PB = WS_PKK + 8 * MiB;
constexpr size_t WS_PKM = WS_PB + 8 * MiB;
constexpr size_t WS_PG = WS_PKM + 8 * MiB;
constexpr size_t WS_O = WS_R;
constexpr size_t WS_GATE = WS_R;
constexpr size_t WS_UP = WS_R + 88 * MiB;
constexpr size_t WS_O2 = WS_R;
constexpr size_t WS_MISC = 235 * MiB;
constexpr size_t WS_QK = 240 * MiB;
constexpr size_t WS_END = 256 * MiB;
constexpr int CW_TMO = 0, CW_BAR = 4096;

constexpr int RING_OFF = 0, RING_BYTES = 131072;
constexpr int LDSCTL_OFF = RING_BYTES, MISC_OFF = LDSCTL_OFF + 320;
constexpr int LDS_BYTES = 147456;

#define GAS __attribute__((address_space(1)))
#define LAS __attribute__((address_space(3)))
typedef unsigned short bf16;
typedef unsigned v4u __attribute__((ext_vector_type(4)));
typedef float f32x4 __attribute__((ext_vector_type(4)));
typedef GAS unsigned gu32;
#define RLX_AGENT __ATOMIC_RELAXED, __HIP_MEMORY_SCOPE_AGENT
#define LDS_WAIT() asm volatile("s_waitcnt lgkmcnt(0)" ::: "memory")
#define DEV __device__ __forceinline__
DEV unsigned f2bf(float f) { unsigned u = __builtin_bit_cast(unsigned, f); return (u + 0x7fffu + ((u >> 16) & 1u)) >> 16; }
DEV unsigned pk2(float lo, float hi) { return f2bf(lo) | (f2bf(hi) << 16); }
DEV float bf2f(bf16 v) { return __uint_as_float(((unsigned)v) << 16); }
DEV float wave_sum(float v) {
#pragma unroll
    for (int o = 1; o < 64; o <<= 1) v += __shfl_xor(v, o);
    return v;
}
DEV float sigmoidf_(float x) { return 1.f / (1.f + expf(-x)); }
DEV float softplusf_(float x) { return fmaxf(x, 0.f) + log1pf(expf(-fabsf(x))); }
DEV float logsigmoidf_(float x) { return fminf(x, 0.f) - log1pf(expf(-fabsf(x))); }

#define XB_TMO      128
#define XB_XCNT(j)  (256  + 64 * (j))
#define XB_XSUB(j)  (1280 + 64 * (j))
#define XB_XGEN(j)  (2304 + 64 * (j))
#define XB_TOP      3328
#define XB_TOPGEN   3392
#define XCD_BAR_WORDS 3456
#define XB_SPIN_CAP (1u << 18)

__device__ __forceinline__ unsigned xb_ld(unsigned* p)              { return __hip_atomic_load(p, __ATOMIC_RELAXED, __HIP_MEMORY_SCOPE_AGENT); }
__device__ __forceinline__ unsigned xb_add(unsigned* p, unsigned v) { return __hip_atomic_fetch_add(p, v, __ATOMIC_RELAXED, __HIP_MEMORY_SCOPE_AGENT); }
__device__ __forceinline__ unsigned xb_xcc_id() { return (unsigned)__builtin_amdgcn_s_getreg((3 << 11) | 20) & 0xFu; }
#define XB_SPIN(cond, bar) do { unsigned _sp = 0; while (cond) { __builtin_amdgcn_s_sleep(1); \
    if ((++_sp & 255u) == 0u) { if (xb_ld(&(bar)[XB_TMO])) break; if (_sp > XB_SPIN_CAP) { atomicAdd(&(bar)[XB_TMO], 1u); break; } } } } while (0)

struct XcdBarrier {
    unsigned* bar; unsigned x;
    volatile LAS unsigned* st;
};

__device__ __forceinline__ XcdBarrier xcd_barrier_post(unsigned* bar, volatile LAS unsigned* st) {
    XcdBarrier b; b.bar = bar; b.x = xb_xcc_id(); b.st = st;
    if (threadIdx.x == 0) (void)xb_add(&bar[XB_XCNT(b.x)], 1u);
    return b;
}
__device__ __forceinline__ void xcd_barrier_complete(unsigned* bar, unsigned x, unsigned& nloc, unsigned& nx) {
    const unsigned G = gridDim.x * gridDim.y * gridDim.z;
    unsigned sum, cnt, mine, sp = 0u;
    for (;;) {
        sum = 0u; cnt = 0u; mine = 0u;
#pragma unroll
        for (unsigned j = 0; j < 16; ++j) { const unsigned c = xb_ld(&bar[XB_XCNT(j)]); sum += c; cnt += (c > 0u) ? 1u : 0u; mine = (j == x) ? c : mine; }
        if (sum == G) break;
        __builtin_amdgcn_s_sleep(1);
        if ((++sp & 255u) == 0u) { if (xb_ld(&bar[XB_TMO])) break; if (sp > XB_SPIN_CAP) { atomicAdd(&bar[XB_TMO], 1u); break; } }
    }
    nloc = mine > 0u ? mine : 1u; nx = cnt > 0u ? cnt : 1u;
}

__device__ __forceinline__ void xcd_barrier(const XcdBarrier& b) {
    asm volatile("s_waitcnt vmcnt(0)" ::: "memory");
    __syncthreads();
    if (threadIdx.x == 0) {
        unsigned* bar = b.bar;
        __builtin_amdgcn_s_waitcnt(0);
        unsigned nloc = b.st[0], nx = b.st[1];
        if (nloc == 0u) { xcd_barrier_complete(bar, b.x, nloc, nx); b.st[0] = nloc; b.st[1] = nx; }
        const unsigned old = xb_add(&bar[XB_XSUB(b.x)], 1u);
        const unsigned gen = old / nloc;
        if (old + 1u == (gen + 1u) * nloc) {
            __builtin_amdgcn_fence(__ATOMIC_RELEASE, "agent");
            asm volatile("s_waitcnt vmcnt(0)" ::: "memory");
            const unsigned og = xb_add(&bar[XB_TOP], 1u);
            const unsigned tg = og / nx;
            if (og + 1u == (tg + 1u) * nx) xb_add(&bar[XB_TOPGEN], 1u);
            else XB_SPIN(xb_ld(&bar[XB_TOPGEN]) == tg, bar);
            __builtin_amdgcn_fence(__ATOMIC_ACQUIRE, "agent");
            xb_add(&bar[XB_XGEN(b.x)], 1u);
            asm volatile("s_waitcnt vmcnt(0)" ::: "memory");
        } else {
            XB_SPIN(xb_ld(&bar[XB_XGEN(b.x)]) == gen, bar);
            __builtin_amdgcn_fence(__ATOMIC_ACQUIRE, "agent");
            asm volatile("s_waitcnt vmcnt(0)" ::: "memory");
        }
    }
    __syncthreads();
}
DEV void p0_transpose_item(const float* W, int ldw, int c0, int ncols, bf16* WT, int K, int row_off, LAS float* scr, int item, int lane) {
    const int nblk = ncols / 32, kb = item / nblk, nb = item % nblk, k0 = 64 * kb, n0 = 32 * nb;
#pragma unroll 8
    for (int i = 0; i < 32; ++i) { const int kk = 2 * i + (lane >> 5); scr[kk * 33 + (lane & 31)] = W[(size_t)(k0 + kk) * ldw + c0 + n0 + (lane & 31)]; }
    LDS_WAIT(); asm volatile("" ::: "memory");
    const int c = lane & 7;
#pragma unroll
    for (int j = 0; j < 4; ++j) { const int n = (lane >> 3) + 8 * j; const LAS float* s = scr + (8 * c) * 33 + n;
        v4u o; o.x = pk2(s[0 * 33], s[1 * 33]); o.y = pk2(s[2 * 33], s[3 * 33]); o.z = pk2(s[4 * 33], s[5 * 33]); o.w = pk2(s[6 * 33], s[7 * 33]);
        *(GAS v4u*)(WT + (size_t)(row_off + n0 + n) * K + k0 + 8 * c) = o; }
    LDS_WAIT(); asm volatile("" ::: "memory");
}
DEV void norm_row(const float* base, const float* o, const float* gpost, float* xout, const float* gpre, bf16* xn, const float* Wg, float* Gr, int lane) {
    f32x4 v[4];
#pragma unroll
    for (int j = 0; j < 4; ++j) v[j] = ((const GAS f32x4*)base)[lane + 64 * j];
    if (o) {
        f32x4 ov[4]; float s = 0.f;
#pragma unroll
        for (int j = 0; j < 4; ++j) { ov[j] = ((const GAS f32x4*)o)[lane + 64 * j]; s += (ov[j].x * ov[j].x + ov[j].y * ov[j].y) + (ov[j].z * ov[j].z + ov[j].w * ov[j].w); }
        const float rs = rsqrtf(wave_sum(s) * (1.f / D) + NORM_EPS);
#pragma unroll
        for (int j = 0; j < 4; ++j) { const f32x4 gp = ((const GAS f32x4*)gpost)[lane + 64 * j]; v[j] = v[j] + ov[j] * rs * gp; }
    }
    if (xout) {
#pragma unroll
        for (int j = 0; j < 4; ++j) ((GAS f32x4*)xout)[lane + 64 * j] = v[j];
    }
    if (xn) {
        float s = 0.f;
#pragma unroll
        for (int j = 0; j < 4; ++j) s += (v[j].x * v[j].x + v[j].y * v[j].y) + (v[j].z * v[j].z + v[j].w * v[j].w);
        const float rs = rsqrtf(wave_sum(s) * (1.f / D) + NORM_EPS);
#pragma unroll
        for (int j = 0; j < 4; ++j) { const f32x4 gp = ((const GAS f32x4*)gpre)[lane + 64 * j]; v[j] = v[j] * rs * gp;
            const unsigned lo = pk2(v[j].x, v[j].y), hi = pk2(v[j].z, v[j].w);
            ((GAS unsigned long long*)xn)[lane + 64 * j] = (unsigned long long)lo | ((unsigned long long)hi << 32);
            v[j].x = __uint_as_float(lo << 16); v[j].y = __uint_as_float(lo & 0xffff0000u); v[j].z = __uint_as_float(hi << 16); v[j].w = __uint_as_float(hi & 0xffff0000u); }
        if (Gr) {
            float mine = 0.f;
#pragma unroll 1
            for (int g = 0; g < 12; ++g) { float d = 0.f;
#pragma unroll
                for (int j = 0; j < 4; ++j) { const f32x4 w = ((const GAS f32x4*)(Wg + g * 1024))[lane + 64 * j]; d += (v[j].x * w.x + v[j].y * w.y) + (v[j].z * w.z + v[j].w * w.w); }
                d = wave_sum(d); if (lane == g) mine = d; }
            if (lane < 16) Gr[lane] = (lane < 12) ? mine : 0.f;
        }
    }
}
DEV float wave_excl_add(float tot, int lane) { float inc = tot;
#pragma unroll
    for (int o = 1; o < 64; o <<= 1) { const float v = __shfl_up(inc, o); if (lane >= o) inc += v; }
    return inc - tot; }
DEV float wave_excl_max(float tot, int lane) { float inc = tot;
#pragma unroll
    for (int o = 1; o < 64; o <<= 1) { const float v = __shfl_up(inc, o); if (lane >= o) inc = fmaxf(inc, v); }
    const float ex = __shfl_up(inc, 1); return lane == 0 ? -INFINITY : ex; }

__constant__ int c_bucket[128] = {0, 1, 2, 3, 4, 5, 6, 7, 8, 9, 10, 11, 12, 13, 14, 15, 16, 16, 16, 17, 17, 18, 18, 18, 19, 19, 19, 20, 20, 20, 20, 21, 21, 21, 21, 22, 22, 22, 22, 22, 23, 23, 23, 23, 23, 23, 24, 24, 24, 24, 24, 24, 25, 25, 25, 25, 25, 25, 25, 26, 26, 26, 26, 26, 26, 26, 26, 27, 27, 27, 27, 27, 27, 27, 27, 27, 27, 28, 28, 28, 28, 28, 28, 28, 28, 28, 28, 29, 29, 29, 29, 29, 29, 29, 29, 29, 29, 29, 29, 30, 30, 30, 30, 30, 30, 30, 30, 30, 30, 30, 30, 30, 30, 31, 31, 31, 31, 31, 31, 31, 31, 31, 31, 31, 31, 31, 31, 31};

struct MixP {
    const bf16* Z; const float* G; bf16* Y;
    float* pw; bf16 *pkk, *pb, *pkm, *pg; bf16* qk; float *fc, *ma, *mMx, *mm;
    const float *mu, *w0, *w_up, *a0, *a_up, *g_up, *k_k, *k_a, *r_k, *ln_w, *ln_b, *cw, *cb, *b_i, *b_f, *mnorm, *sinks, *fox_bf, *rel_bias;
};
DEV void rwkv_scan_unit(const MixP& P, int bh, LAS float* sl, int lane) {
    const int b = bh >> 2, h = bh & 3, c = h * 64 + lane;
    LAS float *sw = sl, *skk = sl + 64, *sb = sl + 128, *sk = sl + 192, *sr = sl + 256;
    float S[64];
#pragma unroll
    for (int k = 0; k < 64; ++k) S[k] = 0.f;
    const float mur = P.mu[c], muv = P.mu[512 + c], rk = P.r_k[c], lw = P.ln_w[c], lb = P.ln_b[c];
    float zr_prev = 0.f, zv_prev = 0.f;
    for (int t = 0; t < T; ++t) {
        const size_t tok = (size_t)b * T + t;
        const float zr = bf2f(P.Z[tok * NZ + c]), zv = bf2f(P.Z[tok * NZ + 512 + c]);
        const float r = zr + mur * (zr_prev - zr), v = zv + muv * (zv_prev - zv);
        zr_prev = zr; zv_prev = zv;
        const float kmod_l = bf2f(P.pkm[tok * 256 + c]);
        sw[lane] = P.pw[tok * 256 + c]; skk[lane] = bf2f(P.pkk[tok * 256 + c]); sb[lane] = bf2f(P.pb[tok * 256 + c]); sk[lane] = kmod_l; sr[lane] = r;
        LDS_WAIT(); asm volatile("" ::: "memory");
        float sa = 0.f;
#pragma unroll
        for (int k = 0; k < 64; ++k) sa -= S[k] * skk[k];
        float yv = 0.f;
#pragma unroll
        for (int k = 0; k < 64; ++k) { S[k] = S[k] * sw[k] + sa * sb[k] + v * sk[k]; yv += S[k] * sr[k]; }
        LDS_WAIT(); asm volatile("" ::: "memory");
        const float mean = wave_sum(yv) * (1.f / 64.f);
        const float dv = yv - mean;
        const float var = wave_sum(dv * dv) * (1.f / 64.f);
        const float yn = dv * rsqrtf(var + 64e-5f) * lw + lb;
        const float bonus = wave_sum(r * kmod_l * rk) * v;
        P.Y[tok * DMIX + c] = (bf16)f2bf((yn + bonus) * bf2f(P.pg[tok * 256 + c]));
    }
}
DEV void mlstm_unit(const MixP& P, int bh, int tb, int lane) {
    const int b = bh >> 2, h = bh & 3, t = tb * 64 + lane; const size_t tok = (size_t)b * T + t;
    float q[32], acc[64];
#pragma unroll
    for (int d = 0; d < 32; ++d) q[d] = bf2f(P.qk[tok * 256 + h * 32 + d]);
#pragma unroll
    for (int d = 0; d < 64; ++d) acc[d] = 0.f;
    float den = 0.f; const float Mx = P.mMx[tok * 4 + h];
    const int smax = tb * 64 + 63;
    for (int s = 0; s <= smax; ++s) {
        const size_t ts = (size_t)b * T + s;
        float dot = 0.f;
#pragma unroll
        for (int d = 0; d < 32; ++d) dot += q[d] * bf2f(P.qk[ts * 256 + 128 + h * 32 + d]);
        const float sc = (s <= t) ? dot * expf(P.ma[ts * 4 + h] - Mx) : 0.f;
        den += sc;
#pragma unroll
        for (int d = 0; d < 64; ++d) acc[d] += sc * bf2f(P.Z[ts * NZ + 1280 + h * 64 + d]);
    }
    const float dn = 1.f / fmaxf(fabsf(den), expf(-P.mm[tok * 4 + h]));
    float ss = 0.f;
#pragma unroll
    for (int d = 0; d < 64; ++d) { acc[d] *= dn; ss += acc[d] * acc[d]; }
    const float rs = rsqrtf(ss * (1.f / 64.f) + NORM_EPS);
#pragma unroll
    for (int d = 0; d < 64; ++d) { const int c = h * 64 + d; P.Y[tok * DMIX + 256 + c] = (bf16)f2bf(acc[d] * rs * P.mnorm[c] * sigmoidf_(bf2f(P.Z[tok * NZ + 1536 + c]))); }
}
DEV void swa_unit(const MixP& P, int bh, int tb, int lane) {
    const int b = bh >> 2, hq = bh & 3, kvh = hq >> 1, t = tb * 64 + lane; const size_t tok = (size_t)b * T + t;
    float q[64], acc[64];
#pragma unroll
    for (int d = 0; d < 64; ++d) { q[d] = bf2f(P.Z[tok * NZ + 1792 + hq * 64 + d]) * 0.125f; acc[d] = 0.f; }
    const float sink = P.sinks[hq];
    float m = sink, l = 1.f;
    for (int dist = 0; dist < 128; ++dist) {
        const int s = t - dist; const bool ok = s >= 0; const size_t ts = (size_t)b * T + (ok ? s : 0);
        float dot = P.rel_bias[c_bucket[dist] * 4 + hq];
#pragma unroll
        for (int d = 0; d < 64; ++d) dot += q[d] * bf2f(P.Z[ts * NZ + 2048 + kvh * 64 + d]);
        if (ok) {
            const float mn = fmaxf(m, dot), f = expf(m - mn), p = expf(dot - mn);
            l = l * f + p; m = mn;
#pragma unroll
            for (int d = 0; d < 64; ++d) acc[d] = acc[d] * f + p * bf2f(P.Z[ts * NZ + 2176 + kvh * 64 + d]);
        }
    }
    const float il = 1.f / l;
#pragma unroll
    for (int d = 0; d < 64; ++d) P.Y[tok * DMIX + 512 + hq * 64 + d] = (bf16)f2bf(acc[d] * il);
}
DEV void fox_unit(const MixP& P, int bh, int tb, int lane) {
    const int b = bh >> 2, h = bh & 3, t = tb * 64 + lane; const size_t tok = (size_t)b * T + t;
    float q[64], acc[64];
#pragma unroll
    for (int d = 0; d < 64; ++d) { q[d] = bf2f(P.Z[tok * NZ + 2304 + h * 64 + d]) * 0.125f; acc[d] = 0.f; }
    float m = -INFINITY, l = 0.f; const float ct = P.fc[tok * 4 + h];
    const int smax = tb * 64 + 63;
    for (int s = 0; s <= smax; ++s) {
        const size_t ts = (size_t)b * T + s;
        float dot = ct - P.fc[ts * 4 + h];
#pragma unroll
        for (int d = 0; d < 64; ++d) dot += q[d] * bf2f(P.Z[ts * NZ + 2560 + h * 64 + d]);
        if (s <= t) {
            const float mn = fmaxf(m, dot), f = expf(m - mn), p = expf(dot - mn);
            l = l * f + p; m = mn;
#pragma unroll
            for (int d = 0; d < 64; ++d) acc[d] = acc[d] * f + p * bf2f(P.Z[ts * NZ + 2816 + h * 64 + d]);
        }
    }
    const float il = 1.f / l;
#pragma unroll
    for (int d = 0; d < 64; ++d) P.Y[tok * DMIX + 768 + h * 64 + d] = (bf16)f2bf(acc[d] * il);
}
DEV void gate_scan_mlstm(const MixP& P, int bh, int lane) {
    const int b = bh >> 2, h = bh & 3; const float bi = P.b_i[h], bf = P.b_f[h];
    float li[32], Fl[32]; float F = 0.f;
#pragma unroll
    for (int j = 0; j < 32; ++j) { const size_t tok = (size_t)b * T + lane * 32 + j;
        const float ip = P.G[tok * 16 + h] + bi, fp = P.G[tok * 16 + 4 + h] + bf;
        li[j] = 15.f * tanhf(ip * (1.f / 15.f)); F += logsigmoidf_(15.f * tanhf(fp * (1.f / 15.f))); Fl[j] = F; }
    const float Fex = wave_excl_add(F, lane);
    float pm = -INFINITY;
#pragma unroll
    for (int j = 0; j < 32; ++j) { Fl[j] += Fex; li[j] = li[j] - Fl[j]; pm = fmaxf(pm, li[j]); }
    float run = wave_excl_max(pm, lane);
#pragma unroll
    for (int j = 0; j < 32; ++j) { const size_t tok = (size_t)b * T + lane * 32 + j; run = fmaxf(run, li[j]); const float Mx = fmaxf(run, 0.f);
        P.ma[tok * 4 + h] = li[j]; P.mMx[tok * 4 + h] = Mx; P.mm[tok * 4 + h] = Fl[j] + Mx; }
}
DEV void gate_scan_fox(const MixP& P, int bh, int lane) {
    const int b = bh >> 2, h = bh & 3; const float bf = P.fox_bf[h];
    float cl[32]; float c = 0.f;
#pragma unroll
    for (int j = 0; j < 32; ++j) { const size_t tok = (size_t)b * T + lane * 32 + j; c += logsigmoidf_(P.G[tok * 16 + 8 + h] + bf); cl[j] = c; }
    const float ex = wave_excl_add(c, lane);
#pragma unroll
    for (int j = 0; j < 32; ++j) { const size_t tok = (size_t)b * T + lane * 32 + j; P.fc[tok * 4 + h] = cl[j] + ex; }
}

typedef float f32x2 __attribute__((ext_vector_type(2)));
#define RW_LOADG(gg) do { _Pragma("unroll") for (int s_ = 0; s_ < 4; ++s_) { const size_t tk = tok0 + (gg) * 4 + s_; \
        nw[s_] = P.pw[tk * 256 + ch]; nkk[s_] = P.pkk[tk * 256 + ch]; nb[s_] = P.pb[tk * 256 + ch]; nkm[s_] = P.pkm[tk * 256 + ch]; nzr[s_] = P.Z[tk * NZ + ch]; nzv[s_] = P.Z[tk * NZ + 512 + ch]; } } while (0)
DEV void rwkv_pass1_unit(const MixP& P, bf16* Zw, float* Pc, float* Sloc, int bh, int c, LAS float* sl, int lane) {
    const int b = bh >> 2, h = bh & 3, ch = h * 64 + lane;
    f32x2 Pm[32], Sm[32];
    int lid = lane; asm volatile("" : "+v"(lid));
#pragma unroll
    for (int j = 0; j < 32; ++j) { Pm[j].x = (2 * j == lid) ? 1.f : 0.f; Pm[j].y = (2 * j + 1 == lid) ? 1.f : 0.f; Sm[j] = (f32x2){0.f, 0.f}; }
    const float mur = P.mu[ch], muv = P.mu[512 + ch];
    const size_t tok0 = (size_t)b * T + c * 64;
    float zr_prev = 0.f, zv_prev = 0.f;
    if (c > 0) { zr_prev = bf2f(P.Z[(tok0 - 1) * NZ + ch]); zv_prev = bf2f(P.Z[(tok0 - 1) * NZ + 512 + ch]); }
    float nw[4]; bf16 nkk[4], nb[4], nkm[4], nzr[4], nzv[4];
    RW_LOADG(0);
#pragma unroll 1
    for (int g = 0; g < 16; ++g) {
#pragma unroll
        for (int s = 0; s < 4; ++s) { const float zr = bf2f(nzr[s]), zv = bf2f(nzv[s]); const float r = zr + mur * (zr_prev - zr); sl[(20 + s) * 64 + lane] = zv + muv * (zv_prev - zv); zr_prev = zr; zv_prev = zv;
            sl[(s * 5 + 0) * 64 + lane] = bf2f(nkk[s]); sl[(s * 5 + 1) * 64 + lane] = nw[s]; sl[(s * 5 + 2) * 64 + lane] = bf2f(nb[s]); sl[(s * 5 + 3) * 64 + lane] = bf2f(nkm[s]); sl[(s * 5 + 4) * 64 + lane] = r; }
        if (g + 1 < 16) RW_LOADG(g + 1);
        LDS_WAIT(); asm volatile("" ::: "memory");
#pragma unroll 1
        for (int s = 0; s < 4; ++s) {
            const LAS f32x4* v4 = (const LAS f32x4*)(sl + s * 5 * 64);
            f32x2 saP2 = (f32x2){0.f, 0.f}, saS2 = (f32x2){0.f, 0.f};
#pragma unroll
            for (int j = 0; j < 16; ++j) { const f32x4 k4 = v4[j]; const f32x2 k01 = (f32x2){k4.x, k4.y}, k23 = (f32x2){k4.z, k4.w};
                saP2 += Pm[2 * j] * k01; saP2 += Pm[2 * j + 1] * k23; saS2 += Sm[2 * j] * k01; saS2 += Sm[2 * j + 1] * k23; }
            const float saP = -(saP2.x + saP2.y), saS = -(saS2.x + saS2.y), v = sl[(20 + s) * 64 + lane];
            f32x2 uP2 = (f32x2){0.f, 0.f}, yS2 = (f32x2){0.f, 0.f};
#pragma unroll
            for (int j = 0; j < 16; ++j) { const f32x4 w4 = v4[16 + j], b4 = v4[32 + j], m4 = v4[48 + j], r4 = v4[64 + j];
                const f32x2 w01 = (f32x2){w4.x, w4.y}, w23 = (f32x2){w4.z, w4.w}, b01 = (f32x2){b4.x, b4.y}, b23 = (f32x2){b4.z, b4.w}, m01 = (f32x2){m4.x, m4.y}, m23 = (f32x2){m4.z, m4.w}, r01 = (f32x2){r4.x, r4.y}, r23 = (f32x2){r4.z, r4.w};
                Pm[2 * j] = Pm[2 * j] * w01 + b01 * saP; Pm[2 * j + 1] = Pm[2 * j + 1] * w23 + b23 * saP;
                Sm[2 * j] = Sm[2 * j] * w01 + (b01 * saS + m01 * v); Sm[2 * j + 1] = Sm[2 * j + 1] * w23 + (b23 * saS + m23 * v);
                uP2 += Pm[2 * j] * r01; uP2 += Pm[2 * j + 1] * r23; yS2 += Sm[2 * j] * r01; yS2 += Sm[2 * j + 1] * r23; }
            const size_t tk = tok0 + g * 4 + s;
            Zw[tk * NZ + 256 + ch] = (bf16)f2bf(uP2.x + uP2.y); P.Y[tk * DMIX + ch] = (bf16)f2bf(yS2.x + yS2.y);
        }
        LDS_WAIT(); asm volatile("" ::: "memory");
    }
    float* pc = Pc + ((size_t)(bh * 32 + c) * 64 + lane) * 64; float* sc = Sloc + ((size_t)(bh * 32 + c) * 64 + lane) * 64;
#pragma unroll
    for (int j = 0; j < 16; ++j) { ((GAS f32x4*)pc)[j] = (f32x4){Pm[2 * j].x, Pm[2 * j].y, Pm[2 * j + 1].x, Pm[2 * j + 1].y}; ((GAS f32x4*)sc)[j] = (f32x4){Sm[2 * j].x, Sm[2 * j].y, Sm[2 * j + 1].x, Sm[2 * j + 1].y}; }
}
DEV void rwkv_c1_unit(const float* Pc, float* Sloc, int bh, int row, LAS float* ss, int lane) {
    float s = 0.f; float pcv[64];
    const float* pc = Pc + (size_t)(bh * 32) * 4096 + lane; float* sc = Sloc + (size_t)(bh * 32) * 4096 + row * 64 + lane;
#pragma unroll
    for (int j = 0; j < 64; ++j) pcv[j] = pc[j * 64];
    float sl_ = sc[0];
#pragma unroll 1
    for (int c = 0; c < 31; ++c) {
        ss[lane] = s; LDS_WAIT(); asm volatile("" ::: "memory");
        float acc = sl_;
#pragma unroll
        for (int j = 0; j < 16; ++j) { const f32x4 s4 = ((const LAS f32x4*)ss)[j]; acc += (s4.x * pcv[4 * j] + s4.y * pcv[4 * j + 1]) + (s4.z * pcv[4 * j + 2] + s4.w * pcv[4 * j + 3]); }
        LDS_WAIT(); asm volatile("" ::: "memory");
        s = acc; float* scc = sc + (size_t)c * 4096;
        if (c + 1 < 31) {
#pragma unroll
            for (int j = 0; j < 64; ++j) pcv[j] = pc[(size_t)(c + 1) * 4096 + j * 64];
            sl_ = scc[4096];
        }
        scc[0] = s;
    }
}
DEV void unpack8(const v4u p, float* o) { o[0] = __uint_as_float(p.x << 16); o[1] = __uint_as_float(p.x & 0xffff0000u); o[2] = __uint_as_float(p.y << 16); o[3] = __uint_as_float(p.y & 0xffff0000u);
    o[4] = __uint_as_float(p.z << 16); o[5] = __uint_as_float(p.z & 0xffff0000u); o[6] = __uint_as_float(p.w << 16); o[7] = __uint_as_float(p.w & 0xffff0000u); }
DEV void rwkv_c2_unit(const MixP& P, const float* S0buf, int bh, int c, LAS float* sl, int lane) {
    const int b = bh >> 2, h = bh & 3; const size_t tok = (size_t)b * T + c * 64 + lane;
#pragma unroll 8
    for (int j = 0; j < 64; ++j) sl[j * 64 + lane] = (c > 0) ? S0buf[((size_t)(bh * 32 + c - 1) * 64 + j) * 64 + lane] : 0.f;
    float U[64];
#pragma unroll
    for (int q = 0; q < 8; ++q) unpack8(*(const GAS v4u*)(P.Z + tok * NZ + 256 + h * 64 + q * 8), U + q * 8);
    LDS_WAIT(); asm volatile("" ::: "memory");
    float sum = 0.f, sq = 0.f;
    const bf16* ylp = P.Y + tok * DMIX + h * 64;
#pragma unroll 2
    for (int i = 0; i < 64; ++i) { float acc = bf2f(ylp[i]);
#pragma unroll
        for (int j = 0; j < 16; ++j) { const f32x4 s4 = ((const LAS f32x4*)(sl + i * 64))[j]; acc += (U[4 * j] * s4.x + U[4 * j + 1] * s4.y) + (U[4 * j + 2] * s4.z + U[4 * j + 3] * s4.w); }
        asm volatile("" ::: "memory");
        sl[i * 64 + lane] = acc; sum += acc; sq += acc * acc; }
    LDS_WAIT(); asm volatile("" ::: "memory");
    const float mean = sum * (1.f / 64.f); const float var = fmaxf(sq * (1.f / 64.f) - mean * mean, 0.f) * 64.f;
    const float rstd = rsqrtf(var * (1.f / 64.f) + 64e-5f);
    const bool has_prev = (c > 0) || (lane > 0);
    float bonus = 0.f;
#pragma unroll 1
    for (int q = 0; q < 8; ++q) { float zc[8], zp[8], km[8];
        unpack8(*(const GAS v4u*)(P.Z + tok * NZ + h * 64 + q * 8), zc); unpack8(*(const GAS v4u*)(P.pkm + tok * 256 + h * 64 + q * 8), km);
        if (has_prev) unpack8(*(const GAS v4u*)(P.Z + (tok - 1) * NZ + h * 64 + q * 8), zp); else {
#pragma unroll
            for (int e = 0; e < 8; ++e) zp[e] = 0.f; }
#pragma unroll
        for (int e = 0; e < 8; ++e) { const int i = h * 64 + q * 8 + e; const float r = zc[e] + P.mu[i] * (zp[e] - zc[e]); bonus += r * km[e] * P.r_k[i]; } }
#pragma unroll 1
    for (int q = 0; q < 8; ++q) { float zc[8], zp[8], gg[8];
        unpack8(*(const GAS v4u*)(P.Z + tok * NZ + 512 + h * 64 + q * 8), zc); unpack8(*(const GAS v4u*)(P.pg + tok * 256 + h * 64 + q * 8), gg);
        if (has_prev) unpack8(*(const GAS v4u*)(P.Z + (tok - 1) * NZ + 512 + h * 64 + q * 8), zp); else {
#pragma unroll
            for (int e = 0; e < 8; ++e) zp[e] = 0.f; }
        v4u o; float ov[8];
#pragma unroll
        for (int e = 0; e < 8; ++e) { const int i = h * 64 + q * 8 + e; const float v = zc[e] + P.mu[512 + i] * (zp[e] - zc[e]); ov[e] = ((sl[(q * 8 + e) * 64 + lane] - mean) * rstd * P.ln_w[i] + P.ln_b[i] + bonus * v) * gg[e]; }
        o.x = pk2(ov[0], ov[1]); o.y = pk2(ov[2], ov[3]); o.z = pk2(ov[4], ov[5]); o.w = pk2(ov[6], ov[7]);
        *(GAS v4u*)(P.Y + tok * DMIX + h * 64 + q * 8) = o; }
}

typedef short s16x8 __attribute__((ext_vector_type(8)));
typedef short s16x4 __attribute__((ext_vector_type(4)));
typedef float f32x16 __attribute__((ext_vector_type(16)));
constexpr int AT_PITCH = 144, AT_KB = 64 * AT_PITCH;
constexpr int AT_K0 = 0, AT_V0 = 2 * AT_KB, AT_KV = 4 * AT_KB;
constexpr int AT_KVEC = AT_KV, AT_BT = AT_KVEC + 512, AT_WS = AT_BT + 512, AT_OST = AT_WS + 8 * 256, AT_END = AT_OST + 8 * 8192;
static_assert(AT_END <= RING_BYTES, "attention LDS map");
constexpr float LOG2E = 1.4426950408889634f;
DEV s16x4 vtr16(const LAS unsigned char* p) { return __builtin_bit_cast(s16x4, __builtin_amdgcn_ds_read_tr16_b64_v4i16((LAS s16x4*)p)); }
DEV unsigned cvtpk(float lo, float hi) { unsigned r; asm volatile("v_cvt_pk_bf16_f32 %0, %1, %2" : "=v"(r) : "v"(lo), "v"(hi)); return r; }
DEV s16x8 scale_frag(const v4u p, float sc) { float f[8]; unpack8(p, f); v4u o; o.x = cvtpk(f[0] * sc, f[1] * sc); o.y = cvtpk(f[2] * sc, f[3] * sc); o.z = cvtpk(f[4] * sc, f[5] * sc); o.w = cvtpk(f[6] * sc, f[7] * sc); return __builtin_bit_cast(s16x8, o); }

template <int KIND>
DEV void attn_unit(const MixP& P, int b, int h, int qb, LAS unsigned char* lds, int tid, int wave, int lane) {
    constexpr int DK = (KIND == 1) ? 32 : 64, NKS = DK / 16;
    const int r32 = lane & 31, hh = lane >> 5;
    const size_t row0 = (size_t)b * T;
    const int kvh = (KIND == 2) ? (h >> 1) : h;
    const bf16* Qp = (KIND == 0) ? P.Z + 2304 + h * 64 : (KIND == 1) ? P.qk + h * 32 : P.Z + 1792 + h * 64;
    const bf16* Kp = (KIND == 0) ? P.Z + 2560 + h * 64 : (KIND == 1) ? P.qk + 128 + h * 32 : P.Z + 2048 + kvh * 64;
    const bf16* Vp = (KIND == 0) ? P.Z + 2816 + h * 64 : (KIND == 1) ? P.Z + 1280 + h * 64 : P.Z + 2176 + kvh * 64;
    constexpr int QPITCH = (KIND == 1) ? 256 : NZ;
    const float* kvec = (KIND == 0) ? P.fc : P.ma;
    const int q0 = qb * 256, qw0 = q0 + wave * 32, qpos = qw0 + r32;
    const int t0 = (KIND == 2) ? ((4 * qb - 2) > 0 ? (4 * qb - 2) : 0) : 0, t1 = 4 * qb + 3;
    LAS float* kv_l = (LAS float*)(lds + AT_KVEC); LAS float* bt = (LAS float*)(lds + AT_BT); LAS float* wsf = (LAS float*)(lds + AT_WS + wave * 256);
    s16x8 qf[NKS];
#pragma unroll
    for (int ds = 0; ds < NKS; ++ds) { const v4u raw = *(const GAS v4u*)(Qp + (row0 + qpos) * QPITCH + ds * 16 + hh * 8);
        qf[ds] = (KIND == 1) ? __builtin_bit_cast(s16x8, raw) : scale_frag(raw, 0.125f * LOG2E); }
    float qrow = 0.f;
    if (KIND == 1) qrow = P.mMx[(row0 + qpos) * 4 + h];
    if (KIND == 2) { if (tid < 128) bt[tid] = P.rel_bias[c_bucket[tid] * 4 + h] * LOG2E; }
    v4u kreg, vreg; float kvr = 0.f;
    const int skey = tid >> 3, sch = tid & 7, skey1 = tid >> 2, sch1 = tid & 3;
#define AT_LOAD(t) do { const size_t kr = row0 + (size_t)(t) * 64; \
        if (KIND == 1) { if (tid < 256) kreg = *(const GAS v4u*)(Kp + (kr + skey1) * 256 + sch1 * 8); } else kreg = *(const GAS v4u*)(Kp + (kr + skey) * NZ + sch * 8); \
        vreg = *(const GAS v4u*)(Vp + (kr + skey) * NZ + sch * 8); \
        if (KIND != 2 && tid < 64) kvr = kvec[(kr + tid) * 4 + h]; } while (0)
#define AT_STORE(buf) do { \
        if (KIND == 1) { if (tid < 256) *(LAS v4u*)(lds + AT_K0 + (buf) * AT_KB + skey1 * AT_PITCH + sch1 * 16) = kreg; } else *(LAS v4u*)(lds + AT_K0 + (buf) * AT_KB + skey * AT_PITCH + sch * 16) = kreg; \
        *(LAS v4u*)(lds + AT_V0 + (buf) * AT_KB + skey * AT_PITCH + sch * 16) = vreg; \
        if (KIND != 2 && tid < 64) kv_l[(buf) * 64 + tid] = kvr; } while (0)
    f32x16 o0, o1;
#pragma unroll
    for (int r = 0; r < 16; ++r) { o0[r] = 0.f; o1[r] = 0.f; }
    float m_run = (KIND == 2) ? P.sinks[h] * LOG2E : -INFINITY, l_run = (KIND == 2) ? 1.f : 0.f;
    if (KIND == 2 && hh == 1) l_run = 0.f;
    AT_LOAD(t0); AT_STORE(0);
    __syncthreads();
#pragma unroll 1
    for (int t = t0; t <= t1; ++t) {
        const int cur = (t - t0) & 1;
        if (t < t1) AT_LOAD(t + 1);
        const int kt0 = t * 64;
        bool need = kt0 <= qw0 + 31;
        if (KIND == 2) need = need && (kt0 + 63 >= qw0 - 127);
        if (need) {
            const LAS unsigned char* Kb = lds + AT_K0 + cur * AT_KB; const LAS unsigned char* Vb = lds + AT_V0 + cur * AT_KB;
            f32x16 p0, p1;
            if (KIND == 0) {
#pragma unroll
                for (int g = 0; g < 4; ++g) { const f32x4 a = *(const LAS f32x4*)(kv_l + cur * 64 + 8 * g + 4 * hh), c = *(const LAS f32x4*)(kv_l + cur * 64 + 32 + 8 * g + 4 * hh);
#pragma unroll
                    for (int e = 0; e < 4; ++e) { p0[4 * g + e] = -a[e] * LOG2E; p1[4 * g + e] = -c[e] * LOG2E; } }
            } else {
#pragma unroll
                for (int r = 0; r < 16; ++r) { p0[r] = 0.f; p1[r] = 0.f; }
            }
#pragma unroll
            for (int ds = 0; ds < NKS; ++ds) {
                const s16x8 a0 = *(const LAS s16x8*)(Kb + r32 * AT_PITCH + ds * 32 + hh * 16);
                const s16x8 a1 = *(const LAS s16x8*)(Kb + (32 + r32) * AT_PITCH + ds * 32 + hh * 16);
                p0 = __builtin_amdgcn_mfma_f32_32x32x16_bf16(a0, qf[ds], p0, 0, 0, 0);
                p1 = __builtin_amdgcn_mfma_f32_32x32x16_bf16(a1, qf[ds], p1, 0, 0, 0);
            }
            const bool band = (kt0 + 63 > qw0) || (KIND == 2 && kt0 < qw0 + 31 - 127 + 1);
            if (KIND == 1) {
                float dsum = 0.f;
#pragma unroll
                for (int g = 0; g < 4; ++g) { const f32x4 a = *(const LAS f32x4*)(kv_l + cur * 64 + 8 * g + 4 * hh), c = *(const LAS f32x4*)(kv_l + cur * 64 + 32 + 8 * g + 4 * hh);
#pragma unroll
                    for (int e = 0; e < 4; ++e) { const int r = 4 * g + e; const int kp = kt0 + 8 * g + 4 * hh + e;
                        float w0 = __builtin_amdgcn_exp2f((a[e] - qrow) * LOG2E), w1 = __builtin_amdgcn_exp2f((c[e] - qrow) * LOG2E);
                        float s0 = p0[r] * w0, s1 = p1[r] * w1;
                        if (band) { if (kp > qpos) s0 = 0.f; if (kp + 32 > qpos) s1 = 0.f; }
                        p0[r] = s0; p1[r] = s1; dsum += s0 + s1; } }
                l_run += dsum;
            } else {
                if (KIND == 2) {
#pragma unroll
                    for (int r = 0; r < 16; ++r) { const int kp = kt0 + (r & 3) + 8 * (r >> 2) + 4 * hh; const int d0 = qpos - kp, d1 = d0 - 32;
                        p0[r] = (d0 >= 0 && d0 < 128) ? p0[r] + bt[d0 & 127] : -INFINITY; p1[r] = (d1 >= 0 && d1 < 128) ? p1[r] + bt[d1 & 127] : -INFINITY; }
                } else if (band) {
#pragma unroll
                    for (int r = 0; r < 16; ++r) { const int kp = kt0 + (r & 3) + 8 * (r >> 2) + 4 * hh; if (kp > qpos) p0[r] = -INFINITY; if (kp + 32 > qpos) p1[r] = -INFINITY; }
                }
                float mx = fmaxf(p0[0], p1[0]);
#pragma unroll
                for (int r = 1; r < 16; ++r) mx = fmaxf(mx, fmaxf(p0[r], p1[r]));
                mx = fmaxf(mx, __shfl_xor(mx, 32));
                const float m_new = fmaxf(m_run, mx);
                if (__any(m_new > m_run)) {
                    const float alpha = __builtin_amdgcn_exp2f(m_run - m_new);
                    l_run *= alpha; m_run = m_new;
                    if (hh == 0) wsf[r32] = alpha;
                    LDS_WAIT(); asm volatile("" ::: "memory");
#pragma unroll
                    for (int g = 0; g < 4; ++g) { const f32x4 a = *(const LAS f32x4*)(wsf + 8 * g + 4 * hh);
#pragma unroll
                        for (int e = 0; e < 4; ++e) { o0[4 * g + e] *= a[e]; o1[4 * g + e] *= a[e]; } }
                    LDS_WAIT(); asm volatile("" ::: "memory");
                }
                float ps = 0.f;
#pragma unroll
                for (int r = 0; r < 16; ++r) { p0[r] = __builtin_amdgcn_exp2f(p0[r] - m_run); p1[r] = __builtin_amdgcn_exp2f(p1[r] - m_run); ps += p0[r] + p1[r]; }
                l_run += ps;
            }
            const LAS unsigned char* vb = Vb + (4 * hh + ((lane & 15) >> 2)) * AT_PITCH + ((lane >> 4) & 1) * 32 + (lane & 3) * 8;
#pragma unroll
            for (int s = 0; s < 4; ++s) {
                v4u pw;
                if (s == 0) { pw.x = cvtpk(p0[0], p0[1]); pw.y = cvtpk(p0[2], p0[3]); pw.z = cvtpk(p0[4], p0[5]); pw.w = cvtpk(p0[6], p0[7]); }
                else if (s == 1) { pw.x = cvtpk(p0[8], p0[9]); pw.y = cvtpk(p0[10], p0[11]); pw.z = cvtpk(p0[12], p0[13]); pw.w = cvtpk(p0[14], p0[15]); }
                else if (s == 2) { pw.x = cvtpk(p1[0], p1[1]); pw.y = cvtpk(p1[2], p1[3]); pw.z = cvtpk(p1[4], p1[5]); pw.w = cvtpk(p1[6], p1[7]); }
                else { pw.x = cvtpk(p1[8], p1[9]); pw.y = cvtpk(p1[10], p1[11]); pw.z = cvtpk(p1[12], p1[13]); pw.w = cvtpk(p1[14], p1[15]); }
                const s16x8 pa = __builtin_bit_cast(s16x8, pw);
                const s16x4 v00 = vtr16(vb + (16 * s) * AT_PITCH), v01 = vtr16(vb + (16 * s + 8) * AT_PITCH);
                const s16x4 v10 = vtr16(vb + (16 * s) * AT_PITCH + 64), v11 = vtr16(vb + (16 * s + 8) * AT_PITCH + 64);
                const s16x8 vf0 = (s16x8){v00[0], v00[1], v00[2], v00[3], v01[0], v01[1], v01[2], v01[3]};
                const s16x8 vf1 = (s16x8){v10[0], v10[1], v10[2], v10[3], v11[0], v11[1], v11[2], v11[3]};
                o0 = __builtin_amdgcn_mfma_f32_32x32x16_bf16(pa, vf0, o0, 0, 0, 0);
                o1 = __builtin_amdgcn_mfma_f32_32x32x16_bf16(pa, vf1, o1, 0, 0, 0);
            }
        }
        if (t < t1) AT_STORE(cur ^ 1);
        __syncthreads();
    }
#undef AT_LOAD
#undef AT_STORE
    float lt = l_run + __shfl_xor(l_run, 32);
    float dn;
    if (KIND == 1) dn = 1.f / fmaxf(fabsf(lt), expf(-P.mm[(row0 + qpos) * 4 + h])); else dn = 1.f / lt;
    if (hh == 0) wsf[r32] = dn;
    LDS_WAIT(); asm volatile("" ::: "memory");
    LAS float* ost = (LAS float*)(lds + AT_OST + wave * 8192);
#pragma unroll
    for (int g = 0; g < 4; ++g) { const f32x4 a = *(const LAS f32x4*)(wsf + 8 * g + 4 * hh);
#pragma unroll
        for (int e = 0; e < 4; ++e) { const int q = 8 * g + 4 * hh + e; ost[q * 64 + r32] = o0[4 * g + e] * a[e]; ost[q * 64 + 32 + r32] = o1[4 * g + e] * a[e]; } }
    LDS_WAIT(); asm volatile("" ::: "memory");
    {
        float v[32];
#pragma unroll
        for (int j = 0; j < 8; ++j) { const f32x4 a = *(const LAS f32x4*)(ost + r32 * 64 + hh * 32 + 4 * j); v[4 * j] = a[0]; v[4 * j + 1] = a[1]; v[4 * j + 2] = a[2]; v[4 * j + 3] = a[3]; }
        const size_t tok = row0 + qpos;
        const int ocol = ((KIND == 0) ? 768 : (KIND == 1) ? 256 : 512) + h * 64 + hh * 32;
        if (KIND == 1) {
            float ss = 0.f;
#pragma unroll
            for (int j = 0; j < 32; ++j) ss += v[j] * v[j];
            ss += __shfl_xor(ss, 32);
            const float rs = rsqrtf(ss * (1.f / 64.f) + NORM_EPS);
#pragma unroll
            for (int j4 = 0; j4 < 4; ++j4) { float og[8]; unpack8(*(const GAS v4u*)(P.Z + tok * NZ + 1536 + h * 64 + hh * 32 + j4 * 8), og);
#pragma unroll
                for (int e = 0; e < 8; ++e) v[j4 * 8 + e] = v[j4 * 8 + e] * rs * P.mnorm[h * 64 + hh * 32 + j4 * 8 + e] * sigmoidf_(og[e]); }
        }
#pragma unroll
        for (int j4 = 0; j4 < 4; ++j4) { v4u o; o.x = cvtpk(v[j4 * 8], v[j4 * 8 + 1]); o.y = cvtpk(v[j4 * 8 + 2], v[j4 * 8 + 3]); o.z = cvtpk(v[j4 * 8 + 4], v[j4 * 8 + 5]); o.w = cvtpk(v[j4 * 8 + 6], v[j4 * 8 + 7]);
            *(GAS v4u*)(P.Y + tok * DMIX + ocol + j4 * 8) = o; }
    }
    __syncthreads();
}

constexpr int PR_ZK = 0, PR_ZKP = 257, PR_AWD = 66048, PR_AAD = PR_AWD + 9216, PR_AGD = PR_AAD + 9216, PR_NRM = PR_AGD + 17408, PR_END = PR_NRM + 1024;
static_assert(PR_END <= RING_BYTES && PR_AWD >= 64 * 257 * 4, "prep LDS map");
DEV float fast_sigmoid(float x) { return __builtin_amdgcn_rcpf(1.f + __builtin_amdgcn_exp2f(-x * LOG2E)); }
DEV float fast_tanh(float x) { return 1.f - 2.f * __builtin_amdgcn_rcpf(1.f + __builtin_amdgcn_exp2f(2.f * LOG2E * x)); }
DEV s16x8 wfrag(const float* W, int ks, int col, int hh) {
    const float* p = W + (size_t)(16 * ks + 8 * hh) * 256 + col; v4u o;
    o.x = cvtpk(p[0], p[256]); o.y = cvtpk(p[512], p[768]); o.z = cvtpk(p[1024], p[1280]); o.w = cvtpk(p[1536], p[1792]); return __builtin_bit_cast(s16x8, o);
}
DEV void rwkv_prep_unit(const MixP& P, int unit, LAS unsigned char* lds, int tid, int wave, int lane) {
    const size_t tok0 = (size_t)unit * 64; const int tloc0 = (int)(tok0 % T);
    LAS float* zk = (LAS float*)(lds + PR_ZK); LAS float* nrm = (LAS float*)(lds + PR_NRM);
#pragma unroll 2
    for (int n = 0; n < 8; ++n) {
        const int id = tid + 512 * n, i = id >> 6, cg = id & 63;
        const int col = cg < 32 ? 256 + 8 * cg : 768 + 8 * (cg - 32);
        float cur[8], prv[8];
        unpack8(*(const GAS v4u*)(P.Z + (tok0 + i) * NZ + col), cur);
        if (tloc0 + i > 0) unpack8(*(const GAS v4u*)(P.Z + (tok0 + i - 1) * NZ + col), prv); else {
#pragma unroll
            for (int e = 0; e < 8; ++e) prv[e] = 0.f; }
        const f32x4 m0 = *(const GAS f32x4*)(P.mu + col), m1 = *(const GAS f32x4*)(P.mu + col + 4);
#pragma unroll
        for (int e = 0; e < 8; ++e) cur[e] = cur[e] + (e < 4 ? m0[e] : m1[e - 4]) * (prv[e] - cur[e]);
        if (cg < 32) {
#pragma unroll
            for (int e = 0; e < 8; ++e) zk[i * PR_ZKP + 8 * cg + e] = cur[e];
        } else {
            if (cg < 40) {
#pragma unroll
                for (int e = 0; e < 8; ++e) cur[e] = fast_tanh(cur[e]);
            } else if (cg >= 48) {
#pragma unroll
                for (int e = 0; e < 8; ++e) cur[e] = fast_sigmoid(cur[e]);
            }
            v4u o; o.x = cvtpk(cur[0], cur[1]); o.y = cvtpk(cur[2], cur[3]); o.z = cvtpk(cur[4], cur[5]); o.w = cvtpk(cur[6], cur[7]);
            LAS unsigned char* dst = cg < 40 ? lds + PR_AWD + i * 144 + (cg - 32) * 16 : cg < 48 ? lds + PR_AAD + i * 144 + (cg - 40) * 16 : lds + PR_AGD + i * 272 + (cg - 48) * 16;
            *(LAS v4u*)dst = o;
        }
    }
    __syncthreads();
    if (wave < 4) { float s = 0.f;
#pragma unroll 8
        for (int j = 0; j < 64; ++j) { const float v = zk[lane * PR_ZKP + wave * 64 + j] * P.k_k[wave * 64 + j]; s += v * v; }
        nrm[wave * 64 + lane] = fmaxf(sqrtf(s), 1e-12f); }
    const int r32 = lane & 31, hh = lane >> 5, ch = wave * 32 + r32, hd = wave >> 1;
    f32x16 aw[2], aa[2], ag[2];
#pragma unroll
    for (int mb = 0; mb < 2; ++mb)
#pragma unroll
        for (int r = 0; r < 16; ++r) { aw[mb][r] = 0.f; aa[mb][r] = 0.f; ag[mb][r] = 0.f; }
#pragma unroll 1
    for (int ks = 0; ks < 4; ++ks) { const s16x8 bw = wfrag(P.w_up, ks, ch, hh), ba = wfrag(P.a_up, ks, ch, hh);
#pragma unroll
        for (int mb = 0; mb < 2; ++mb) {
            const s16x8 fw = *(const LAS s16x8*)(lds + PR_AWD + (32 * mb + r32) * 144 + ks * 32 + hh * 16), fa = *(const LAS s16x8*)(lds + PR_AAD + (32 * mb + r32) * 144 + ks * 32 + hh * 16);
            aw[mb] = __builtin_amdgcn_mfma_f32_32x32x16_bf16(fw, bw, aw[mb], 0, 0, 0); aa[mb] = __builtin_amdgcn_mfma_f32_32x32x16_bf16(fa, ba, aa[mb], 0, 0, 0); } }
#pragma unroll 1
    for (int ks = 0; ks < 8; ++ks) { const s16x8 bg = wfrag(P.g_up, ks, ch, hh);
#pragma unroll
        for (int mb = 0; mb < 2; ++mb) { const s16x8 fg = *(const LAS s16x8*)(lds + PR_AGD + (32 * mb + r32) * 272 + ks * 32 + hh * 16); ag[mb] = __builtin_amdgcn_mfma_f32_32x32x16_bf16(fg, bg, ag[mb], 0, 0, 0); } }
    __syncthreads();
    const float w0 = P.w0[ch], a0 = P.a0[ch], kkc = P.k_k[ch], kac = P.k_a[ch];
#pragma unroll
    for (int mb = 0; mb < 2; ++mb)
#pragma unroll
        for (int r = 0; r < 16; ++r) {
            const int i = 32 * mb + (r & 3) + 8 * (r >> 2) + 4 * hh; const size_t o = (tok0 + i) * 256 + ch;
            const float wp = w0 + aw[mb][r];
            const float sp = fmaxf(-wp, 0.f) + __logf(1.f + __builtin_amdgcn_exp2f(-fabsf(wp) * LOG2E));
            const float w = __builtin_amdgcn_exp2f(-LOG2E * __builtin_amdgcn_exp2f((-sp - 0.5f) * LOG2E));
            const float a = fast_sigmoid(a0 + aa[mb][r]);
            const float kraw = zk[i * PR_ZKP + ch];
            const float kk = kraw * kkc / nrm[hd * 64 + i];
            P.pw[o] = w; P.pkk[o] = (bf16)f2bf(kk); P.pb[o] = (bf16)f2bf(kk * a); P.pkm[o] = (bf16)f2bf(kraw * (1.f + (a - 1.f) * kac)); P.pg[o] = (bf16)f2bf(ag[mb][r]);
            if ((r & 3) == 3) asm volatile("" ::: "memory");
        }
    __syncthreads();
}

struct Args { const float* in[30]; float* out; unsigned char* ws; int ph_lo, ph_hi, li, pad; };
template <int l> DEV void layer_body(const Args& args, LAS unsigned char* L, const XcdBarrier& bar, const int tid, const int lane, const int wave, const int G, const int bx, const int gw, const int NGW, gu32* ctl) {
    unsigned char* ws = args.ws;
    const int lo = args.ph_lo, hi = args.ph_hi;
#define IN(k) (lo <= (k) && (k) < hi)
#define SEAM(k) do { if (IN(k) && IN((k) + 1)) { if (MK_PER_PHASE) { if (tid == 0) __hip_atomic_store(ctl + CW_TMO, 0xBADBA0u, RLX_AGENT); } else xcd_barrier(bar); } } while (0)

    bf16* Win_t = (bf16*)(ws + WS_WIN); bf16* Wout_t = (bf16*)(ws + WS_WOUT); bf16* Wup_t = (bf16*)(ws + WS_WUP); bf16* Wdn_t = (bf16*)(ws + WS_WDN);
    float* Wg = (float*)(ws + WS_WG);
    bf16* XN = (bf16*)(ws + WS_XN); bf16* Z = (bf16*)(ws + WS_Z); bf16* Y = (bf16*)(ws + WS_Y);
    float* O = (float*)(ws + WS_O); bf16* GATE = (bf16*)(ws + WS_GATE); bf16* UP = (bf16*)(ws + WS_UP); float* O2 = (float*)(ws + WS_O2);
    float* Gg = (float*)(ws + WS_MISC);
    float* X = args.out;


        const int pb = l * PH_PER_LAYER;
        const float* w_in = args.in[1] + (size_t)l * D * NIN; const float* w_out = args.in[2] + (size_t)l * DMIX * D;
        const float* g_mix_pre = args.in[3] + l * D; const float* g_mix_post = args.in[4] + l * D; const float* g_ffn_pre = args.in[5] + l * D; const float* g_ffn_post = args.in[6] + l * D;
        const float* w_up = args.in[26] + (size_t)l * D * NUP; const float* fcw = args.in[27] + (size_t)l * 3 * DFF; const float* fcb = args.in[28] + (size_t)l * DFF; const float* w_dn = args.in[29] + (size_t)l * DFF * D;
        MixP P; float* RPc = (float*)(ws + WS_XN); float* RSl = RPc + (size_t)1024 * 4096;
        P.Z = Z; P.G = Gg; P.Y = Y; P.pw = (float*)(ws + WS_PW); P.pkk = (bf16*)(ws + WS_PKK); P.pb = (bf16*)(ws + WS_PB); P.pkm = (bf16*)(ws + WS_PKM); P.pg = (bf16*)(ws + WS_PG); P.qk = (bf16*)(ws + WS_QK);
        P.fc = Gg + (size_t)M * 16; P.ma = P.fc + (size_t)M * 4; P.mMx = P.ma + (size_t)M * 4; P.mm = P.mMx + (size_t)M * 4;
        P.mu = args.in[7] + l * 1024; P.w0 = args.in[8] + l * 256; P.w_up = args.in[9] + l * 64 * 256; P.a0 = args.in[10] + l * 256; P.a_up = args.in[11] + l * 64 * 256; P.g_up = args.in[12] + l * 128 * 256;
        P.k_k = args.in[13] + l * 256; P.k_a = args.in[14] + l * 256; P.r_k = args.in[15] + l * 256; P.ln_w = args.in[16] + l * 256; P.ln_b = args.in[17] + l * 256;
        P.cw = args.in[18] + l * 4 * 256; P.cb = args.in[19] + l * 256; P.b_i = args.in[20] + l * 4; P.b_f = args.in[21] + l * 4; P.mnorm = args.in[22] + l * 256; P.sinks = args.in[23] + l * 4; P.fox_bf = args.in[24] + l * 4; P.rel_bias = args.in[25];

        if (IN(pb + 0)) {
            LAS float* scr = (LAS float*)(L + RING_OFF + wave * 16384);
            constexpr int I_A = 16 * 56, I_B = 16 * 40, I_O = 16 * 32, I_U = 16 * 176, I_D = 44 * 32, NITEMS = I_A + I_B + I_O + I_U + I_D;
            for (int it = gw; it < NITEMS; it += NGW) {
                int r = it;
                if (r < I_A) { p0_transpose_item(w_in, NIN, 0, 1792, Win_t, D, 0, scr, r, lane); continue; } r -= I_A;
                if (r < I_B) { p0_transpose_item(w_in, NIN, 1800, 1280, Win_t, D, 1792, scr, r, lane); continue; } r -= I_B;
                if (r < I_O) { p0_transpose_item(w_out, D, 0, D, Wout_t, DMIX, 0, scr, r, lane); continue; } r -= I_O;
                if (r < I_U) { p0_transpose_item(w_up, NUP, 0, NUP, Wup_t, D, 0, scr, r, lane); continue; } r -= I_U;
                p0_transpose_item(w_dn, D, 0, D, Wdn_t, DFF, 0, scr, r, lane);
            }
            for (int i = bx * 512 + tid; i < 16 * 1024; i += G * 512) { const int g = i >> 10, k = i & 1023; const int col = g < 4 ? 1792 + g : (g < 8 ? 1796 + (g - 4) : 3080 + (g - 8)); Wg[i] = g < 12 ? w_in[(size_t)k * NIN + col] : 0.f; }
            if (l == 0) {
                for (int m = gw; m < M; m += NGW) norm_row(args.in[0] + (size_t)m * D, nullptr, nullptr, X + (size_t)m * D, g_mix_pre, XN + (size_t)m * D, nullptr, nullptr, lane);
            }
        }
        SEAM(pb + 0);
        if (IN(pb + 1)) {
            {
                pg8::Gemm g{XN, Win_t, M, NZ, D}; pg8::StaticOrder S; S.init(M, NZ, G, bx);
                pg8::EpiBf16<0> E{Z, NZ, nullptr, 0, 0, 1.f};
                pg8::gemm_phase<pg8::EpiBf16<0>, pg8::StaticOrder, true, true>(L + RING_OFF, g, S, E);
            }
            for (int m = gw; m < M; m += NGW) {
                f32x4 v[4];
#pragma unroll
                for (int j = 0; j < 4; ++j) { const unsigned long long p = ((const GAS unsigned long long*)(XN + (size_t)m * D))[lane + 64 * j]; const unsigned lo_ = (unsigned)p, hi_ = (unsigned)(p >> 32);
                    v[j].x = __uint_as_float(lo_ << 16); v[j].y = __uint_as_float(lo_ & 0xffff0000u); v[j].z = __uint_as_float(hi_ << 16); v[j].w = __uint_as_float(hi_ & 0xffff0000u); }
                float mine = 0.f;
#pragma unroll 1
                for (int g = 0; g < 12; ++g) { float d = 0.f;
#pragma unroll
                    for (int j = 0; j < 4; ++j) { const f32x4 w = ((const GAS f32x4*)(Wg + g * 1024))[lane + 64 * j]; d += (v[j].x * w.x + v[j].y * w.y) + (v[j].z * w.z + v[j].w * w.w); }
                    d = wave_sum(d); if (lane == g) mine = d; }
                if (lane < 16) Gg[(size_t)m * 16 + lane] = (lane < 12) ? mine : 0.f;
            }
        }
        SEAM(pb + 1);
        if (IN(pb + 2)) {
            for (int u = bx; u < M / 64; u += G) rwkv_prep_unit(P, u, L + RING_OFF, tid, wave, lane);
            for (int i = bx * 512 + tid; i < M * 256; i += G * 512) {
                const int tok = i >> 8, c2 = i & 255, t = tok % T;
                float s = P.cb[c2];
#pragma unroll
                for (int j = 0; j < 4; ++j) { const int tt = t - 3 + j; if (tt >= 0) s += P.cw[j * 256 + c2] * bf2f(Z[(size_t)(tok - 3 + j) * NZ + 1024 + c2]); }
                s = s * sigmoidf_(s);
                if (c2 < 128) s *= 0.17677669529663687f;
                P.qk[i] = (bf16)f2bf(s);
            }
            if (wave == 1 && bx < 64) { if (bx < 32) gate_scan_mlstm(P, bx, lane); else gate_scan_fox(P, bx - 32, lane); }
        }
        SEAM(pb + 2);
        if (IN(pb + 3)) {
            if (wave < 4) for (int u = bx * 4 + wave; u < 1024; u += G * 4) rwkv_pass1_unit(P, Z, RPc, RSl, u >> 5, u & 31, (LAS float*)(L + RING_OFF + wave * 8192), lane);
            __syncthreads();
            for (int u = bx; u < 512; u += G) {
                const int kind = u >> 8, rem = u & 255, bh = rem >> 3, s_ = rem & 7, qbA = (s_ & 1) ? 7 - (s_ >> 1) : (s_ >> 1);
                if (kind == 0) attn_unit<0>(P, bh >> 2, bh & 3, qbA, L + RING_OFF, tid, wave, lane); else attn_unit<1>(P, bh >> 2, bh & 3, 7 - qbA, L + RING_OFF, tid, wave, lane);
            }
            for (int u = bx; u < 256; u += G) attn_unit<2>(P, u >> 5, (u >> 3) & 3, u & 7, L + RING_OFF, tid, wave, lane);
        }
        SEAM(pb + 3);
        if (IN(pb + 4)) {
            for (int u = bx * 8 + wave; u < 2048; u += G * 8) rwkv_c1_unit(RPc, RSl, u >> 6, u & 63, (LAS float*)(L + RING_OFF + wave * 1024), lane);
        }
        SEAM(pb + 4);
        if (IN(pb + 5)) {
            for (int u = gw; u < 1024; u += NGW) rwkv_c2_unit(P, RSl, u >> 5, u & 31, (LAS float*)(L + RING_OFF + wave * 16384), lane);
        }
        SEAM(pb + 5);
        if (IN(pb + 6)) {
            pg8::Gemm g{Y, Wout_t, M, D, DMIX}; pg8::StaticOrder S; S.init(M, D, G, bx);
            pg8::EpiF32 E{O, D};
            pg8::gemm_phase<pg8::EpiF32, pg8::StaticOrder, true, true>(L + RING_OFF, g, S, E);
        }
        SEAM(pb + 6);
        if (IN(pb + 7)) {
            for (int m = gw; m < M; m += NGW) norm_row(X + (size_t)m * D, O + (size_t)m * D, g_mix_post, X + (size_t)m * D, g_ffn_pre, XN + (size_t)m * D, nullptr, nullptr, lane);
        }
        SEAM(pb + 7);
        if (IN(pb + 8)) {
            pg8::Gemm g{XN, Wup_t, M, NUP, D}; pg8::StaticOrder S; S.init(M, NUP, G, bx);
            pg8::EpiBf16<0> E{GATE, DFF, nullptr, DFF, (size_t)(WS_UP - WS_GATE) / 2, 1.f};
            pg8::gemm_phase<pg8::EpiBf16<0>, pg8::StaticOrder, true, true>(L + RING_OFF, g, S, E);
        }
        SEAM(pb + 8);
        if (IN(pb + 9)) {
            for (int tok = bx; tok < M; tok += G) {
                const int t = tok % T;
                for (int c = tid; c < DFF; c += 512) {
                    float gv = fcb[c] + fcw[2 * DFF + c] * bf2f(GATE[(size_t)tok * DFF + c]);
                    if (t >= 1) gv += fcw[1 * DFF + c] * bf2f(GATE[(size_t)(tok - 1) * DFF + c]);
                    if (t >= 2) gv += fcw[0 * DFF + c] * bf2f(GATE[(size_t)(tok - 2) * DFF + c]);
                    const float ge = 0.5f * gv * (1.f + tanhf(0.7978845608028654f * (gv + 0.044715f * gv * gv * gv)));
                    UP[(size_t)tok * DFF + c] = (bf16)f2bf(ge * bf2f(UP[(size_t)tok * DFF + c]));
                }
            }
        }
        SEAM(pb + 9);
        if (IN(pb + 10)) {
            pg8::Gemm g{UP, Wdn_t, M, D, DFF}; pg8::StaticOrder S; S.init(M, D, G, bx);
            pg8::EpiF32 E{O2, D};
            pg8::gemm_phase<pg8::EpiF32, pg8::StaticOrder, true, true>(L + RING_OFF, g, S, E);
        }
        SEAM(pb + 10);
        if (IN(pb + 11)) {
            const float* gnext = args.in[3] + D;
            for (int m = gw; m < M; m += NGW) norm_row(X + (size_t)m * D, O2 + (size_t)m * D, g_ffn_post, X + (size_t)m * D, gnext, l == 0 ? XN + (size_t)m * D : nullptr, nullptr, nullptr, lane);
        }
        SEAM(pb + 11);

#undef IN
#undef SEAM
}
__global__ void __launch_bounds__(NWAVES * 64, 2) mk_fwd(Args args) {
    extern __shared__ __attribute__((aligned(16))) unsigned char lds[];
    LAS unsigned char* L = (LAS unsigned char*)lds;
    volatile LAS unsigned* MISC = (volatile LAS unsigned*)(L + MISC_OFF);
    const int tid = threadIdx.x, lane = tid & 63, wave = __builtin_amdgcn_readfirstlane(tid >> 6);
    const int G = gridDim.x, bx = blockIdx.x;
    const int vcu = (G % 8 == 0) ? (bx % 8) * (G / 8) + bx / 8 : bx;
    const int gw = vcu * NWAVES + wave, NGW = G * NWAVES;
    unsigned char* ws = args.ws;
    gu32* ctl = (gu32*)(ws + WS_CTL);
    for (int u = tid; u < (LDS_BYTES - LDSCTL_OFF) / 4; u += NWAVES * 64) ((LAS unsigned*)(L + LDSCTL_OFF))[u] = 0u;
    __syncthreads();
    XcdBarrier bar; bar.bar = (unsigned*)(ctl + CW_BAR); bar.x = 0; bar.st = nullptr;
    if (!MK_PER_PHASE) bar = xcd_barrier_post((unsigned*)(ctl + CW_BAR), MISC + 8);
    layer_body<0>(args, L, bar, tid, lane, wave, G, bx, gw, NGW, ctl);
    layer_body<1>(args, L, bar, tid, lane, wave, G, bx, gw, NGW, ctl);
}

extern "C" void kernel_launch(void* const* d_in, const int* in_sizes, int n_in, void* d_out, int out_size, void* d_ws, size_t ws_size, hipStream_t stream) {
    static int grid = 0;
    if (grid == 0) {
        if (n_in != 30 || out_size != M * D || ws_size < WS_END) { fprintf(stderr, "kernel_launch: unexpected shapes (n_in %d out %d ws %zu)\n", n_in, out_size, ws_size); grid = -1; return; }
        int dev = 0, cus = 0, per_cu = 0;
        if (hipGetDevice(&dev) != hipSuccess || hipDeviceGetAttribute(&cus, hipDeviceAttributeMultiprocessorCount, dev) != hipSuccess) { grid = -1; return; }
        if (hipFuncSetAttribute((const void*)mk_fwd, hipFuncAttributeMaxDynamicSharedMemorySize, LDS_BYTES) != hipSuccess) { fprintf(stderr, "kernel_launch: hipFuncSetAttribute failed\n"); grid = -1; return; }
        if (hipOccupancyMaxActiveBlocksPerMultiprocessor(&per_cu, (const void*)mk_fwd, NWAVES * 64, LDS_BYTES) != hipSuccess || per_cu < 1) { fprintf(stderr, "kernel_launch: occupancy query says %d blocks/CU\n", per_cu); }
        (void)hipGetLastError();
        grid = cus;
    }
    if (grid < 0) return;
    if (hipMemsetAsync((char*)d_ws + WS_CTL, 0, CTL_ZERO_BYTES, stream) != hipSuccess) return;
    Args a{};
    for (int i = 0; i < 30; ++i) a.in[i] = (const float*)d_in[i];
    a.out = (float*)d_out; a.ws = (unsigned char*)d_ws;
#if MK_PER_PHASE
    for (int p = 0; p < N_PHASES; ++p) { a.ph_lo = p; a.ph_hi = p + 1; a.li = p; hipLaunchKernelGGL(mk_fwd, dim3(grid), dim3(NWAVES * 64), LDS_BYTES, stream, a); }
#else
    a.ph_lo = 0; a.ph_hi = N_PHASES; a.li = 0;
    hipLaunchKernelGGL(mk_fwd, dim3(grid), dim3(NWAVES * 64), LDS_BYTES, stream, a);
#endif
}
```
